# Optimizing an MI355X kernel written in HIP

```python
import math
import jax
import jax.numpy as jnp
from jax import lax
import numpy as np

D_MODEL = 2048
BATCH = 2
SEQ = 4096
DEPTH = 4

GRID_W = 64
CTX_LEN = 256
N_MIXERS = 3
N_LAYERS_A = (DEPTH + 2) // N_MIXERS
N_LAYERS_B = (DEPTH + 1) // N_MIXERS
N_LAYERS_C = DEPTH // N_MIXERS
N_MOD = 9
D_FF = 5632
RMS_EPS = 1e-6
NEG_INF = -1e30
CHUNK = 128
A_WIDTH = D_MODEL
A_GROUPS = 16
A_GROUP_DIM = A_WIDTH // A_GROUPS
N_HEADS = 16
HEAD_DIM = D_MODEL // N_HEADS
WIN_H = 8
WIN_W = 16
C_WIDTH = D_MODEL
C_GROUP = 16
C_GROUPS = C_WIDTH // C_GROUP
C_STATE = 64
DT_MIN = 1e-3
DT_MAX = 1e-1

kernel_name = "hybrid_dit_gmlp_nat_s5"


def _rms_norm(x, gain):
    xf = x.astype(jnp.float32)
    xf = xf * lax.rsqrt(jnp.mean(xf * xf, axis=-1, keepdims=True) + RMS_EPS)
    return (xf * gain.astype(jnp.float32)).astype(x.dtype)


def _adaln(cond, w, b):
    m = jax.nn.silu(cond) @ w + b
    return m.reshape(cond.shape[0], N_MOD, D_MODEL)


def _sublayer_in(h, gain, mod, s):
    shift = mod[:, 3 * s, None, :]
    scale = mod[:, 3 * s + 1, None, :]
    return _rms_norm(h, gain) * (1.0 + scale) + shift


def _sublayer_gate(mod, s):
    return mod[:, 3 * s + 2, None, :]


def _swiglu(x, w_gu, w_down):
    g, u = jnp.split(x @ w_gu, 2, axis=-1)
    return (jax.nn.silu(g) * u) @ w_down


def _chunk_gmlp(x, w_in, v_gain, w_s, b_s, w_out):
    bsz, length, _ = x.shape
    u, v = jnp.split(jax.nn.gelu(x @ w_in), 2, axis=-1)
    v = _rms_norm(v, v_gain).reshape(bsz, length // CHUNK, CHUNK, A_GROUPS, A_GROUP_DIM)
    s = jnp.einsum("gpq,bnqgc->bnpgc", w_s, v) + b_s.T[None, None, :, :, None]
    return (u * s.reshape(bsz, length, A_WIDTH)) @ w_out


def _nat_project(h, w_qkv, q_gain, k_gain):
    bsz, length, _ = h.shape
    qkv = (h @ w_qkv).reshape(bsz, length, 3, N_HEADS, HEAD_DIM)
    return _rms_norm(qkv[:, :, 0], q_gain), _rms_norm(qkv[:, :, 1], k_gain), qkv[:, :, 2]


def _neighbourhood_attention(h, hc, w_qkv, q_gain, k_gain, rpb, w_out, ctx_out):
    bsz, length, _ = h.shape
    rows = length // GRID_W
    kh = min(WIN_H, rows)
    scale = HEAD_DIM ** -0.5
    q, k, v = _nat_project(h, w_qkv, q_gain, k_gain)
    qc, kc, vc = _nat_project(hc, w_qkv, q_gain, k_gain)
    grid = (bsz, rows, GRID_W, N_HEADS, HEAD_DIM)
    q, k, v = q.reshape(grid), k.reshape(grid), v.reshape(grid)
    qcol = jnp.arange(GRID_W)[:, None]
    kcol = jnp.arange(GRID_W)[None, :]
    cstart = jnp.clip(qcol - WIN_W // 2, 0, GRID_W - WIN_W)
    col_valid = (kcol >= cstart) & (kcol < cstart + WIN_W)
    dc_idx = jnp.clip(kcol - qcol, 1 - WIN_W, WIN_W - 1) + (WIN_W - 1)
    n_win = kh * GRID_W

    def row_block(r):
        rstart = jnp.clip(r - kh // 2, 0, rows - kh)
        q_r = lax.dynamic_index_in_dim(q, r, axis=1, keepdims=False)
        k_r = lax.dynamic_slice_in_dim(k, rstart, kh, axis=1)
        v_r = lax.dynamic_slice_in_dim(v, rstart, kh, axis=1)
        dr_idx = rstart + jnp.arange(kh) - r + (WIN_H - 1)
        bias = rpb[:, dr_idx[None, :, None], dc_idx[:, None, :]]
        s_win = jnp.einsum("bqhd,bjkhd->bhqjk", q_r, k_r, preferred_element_type=jnp.float32) * scale
        s_win = jnp.where(col_valid[:, None, :], s_win + bias, NEG_INF)
        s_ctx = jnp.einsum("bqhd,bchd->bhqc", q_r, kc, preferred_element_type=jnp.float32) * scale
        p = jax.nn.softmax(jnp.concatenate([s_win.reshape(bsz, N_HEADS, GRID_W, n_win), s_ctx], axis=-1), axis=-1)
        p_win = p[..., :n_win].reshape(bsz, N_HEADS, GRID_W, kh, GRID_W).astype(v.dtype)
        p_ctx = p[..., n_win:].astype(vc.dtype)
        return jnp.einsum("bhqjk,bjkhd->bqhd", p_win, v_r) + jnp.einsum("bhqc,bchd->bqhd", p_ctx, vc)

    o = lax.map(row_block, jnp.arange(rows))
    y = jnp.moveaxis(o, 0, 1).reshape(bsz, length, D_MODEL) @ w_out
    y_ctx = None
    if ctx_out:
        s = jnp.einsum("bqhd,bkhd->bhqk", qc, kc, preferred_element_type=jnp.float32) * scale
        p = jax.nn.softmax(s, axis=-1).astype(vc.dtype)
        y_ctx = jnp.einsum("bhqk,bkhd->bqhd", p, vc).reshape(bsz, hc.shape[1], D_MODEL) @ w_out
    return y, y_ctx


def _ssm_combine(e1, e2):
    a1, b1 = e1
    a2, b2 = e2
    return a1 * a2, a2 * b1 + b2


def _s5_direction(u, uc, a_re, a_im, log_dt, b_re, b_im, c_re, c_im, reverse, ctx_out):
    f32 = jnp.float32
    lam = lax.complex(a_re.astype(f32), a_im.astype(f32))
    dt = jnp.exp(log_dt.astype(f32))[:, None]
    a_bar = jnp.exp(lam * dt)
    b_bar = ((a_bar - 1.0) / lam)[..., None] * lax.complex(b_re.astype(f32), b_im.astype(f32))
    b_bar_re, b_bar_im = jnp.real(b_bar), jnp.imag(b_bar)
    c_re32, c_im32 = c_re.astype(f32), c_im.astype(f32)

    def drive(w):
        wg = w.astype(f32).reshape(w.shape[0], w.shape[1], C_GROUPS, C_GROUP)
        return lax.complex(jnp.einsum("gpc,blgc->blgp", b_bar_re, wg),
                           jnp.einsum("gpc,blgc->blgp", b_bar_im, wg))

    def scan(bu):
        a = jnp.broadcast_to(a_bar, (1,) + bu.shape[1:])
        return lax.associative_scan(_ssm_combine, (a, bu), reverse=reverse, axis=1)[1]

    def readout(hs):
        y = (jnp.einsum("gcp,blgp->blgc", c_re32, jnp.real(hs))
             - jnp.einsum("gcp,blgp->blgc", c_im32, jnp.imag(hs)))
        return y.reshape(hs.shape[0], hs.shape[1], C_WIDTH)

    hs_ctx = scan(drive(uc))
    h0 = hs_ctx[:, 0] if reverse else hs_ctx[:, -1]
    start = -1 if reverse else 0
    bu = drive(u).at[:, start].add(a_bar * h0)
    y = readout(scan(bu))
    y_ctx = readout(hs_ctx) if ctx_out else None
    return y, y_ctx


def _glu(y, w_glu):
    a, g = jnp.split(jax.nn.gelu(y) @ w_glu, 2, axis=-1)
    return a * jax.nn.sigmoid(g)


def _s5_mixer(h, hc, w_in, a_re, a_im, log_dt, b_re, b_im, c_re, c_im, d_skip, w_glu, ctx_out):
    u = h @ w_in
    uc = hc @ w_in
    y = d_skip * u.astype(jnp.float32)
    y_ctx = d_skip * uc.astype(jnp.float32) if ctx_out else None
    for di, rev in enumerate((False, True)):
        yd, yd_ctx = _s5_direction(u, uc, a_re[di], a_im[di], log_dt[di], b_re[di], b_im[di],
                                   c_re[di], c_im[di], rev, ctx_out)
        y = y + yd
        if ctx_out:
            y_ctx = y_ctx + yd_ctx
    out_ctx = _glu(y_ctx, w_glu) if ctx_out else None
    return _glu(y, w_glu), out_ctx


def setup_inputs(seed: int = 0) -> dict:
    key = jax.random.key(seed)
    ks = iter(jax.random.split(key, 40))
    f32 = jnp.float32

    def nrm(shape, s):
        return jax.random.normal(next(ks), shape, f32) * s

    D = D_MODEL
    n_idx = jnp.arange(C_STATE, dtype=f32)
    return {
        "x": nrm((BATCH, SEQ, D), 1.0),
        "c": nrm((BATCH, D), 1.0),
        "ctx": nrm((BATCH, CTX_LEN, D), 1.0),
        "c_ctx": nrm((D,), 1.0),
        "w_ada": nrm((DEPTH, D, N_MOD * D), 0.5 * D ** -0.5),
        "b_ada": nrm((DEPTH, N_MOD * D), 0.02),
        "norm_g": 1.0 + nrm((DEPTH, 3, D), 0.02),
        "ffn_w_gu": nrm((DEPTH, 2, D, 2 * D_FF), D ** -0.5),
        "ffn_w_down": nrm((DEPTH, 2, D_FF, D), D_FF ** -0.5),
        "a_w_in": nrm((N_LAYERS_A, D, 2 * A_WIDTH), D ** -0.5),
        "a_v_gain": 1.0 + nrm((N_LAYERS_A, A_WIDTH), 0.02),
        "a_w_s": nrm((N_LAYERS_A, A_GROUPS, CHUNK, CHUNK), CHUNK ** -0.5),
        "a_b_s": nrm((N_LAYERS_A, A_GROUPS, CHUNK), 0.02),
        "a_w_out": nrm((N_LAYERS_A, A_WIDTH, D), A_WIDTH ** -0.5),
        "b_w_qkv": nrm((N_LAYERS_B, D, 3 * D), D ** -0.5),
        "b_q_gain": 1.0 + nrm((N_LAYERS_B, HEAD_DIM), 0.02),
        "b_k_gain": 1.0 + nrm((N_LAYERS_B, HEAD_DIM), 0.02),
        "b_rpb": nrm((N_LAYERS_B, N_HEADS, 2 * WIN_H - 1, 2 * WIN_W - 1), 0.02),
        "b_w_out": nrm((N_LAYERS_B, D, D), D ** -0.5),
        "c_w_in": nrm((N_LAYERS_C, D, C_WIDTH), D ** -0.5),
        "c_a_re": -0.5 + nrm((N_LAYERS_C, 2, C_GROUPS, C_STATE), 0.01),
        "c_a_im": math.pi * n_idx + nrm((N_LAYERS_C, 2, C_GROUPS, C_STATE), 0.01),
        "c_log_dt": jax.random.uniform(next(ks), (N_LAYERS_C, 2, C_GROUPS), f32,
                                       minval=math.log(DT_MIN), maxval=math.log(DT_MAX)),
        "c_b_re": nrm((N_LAYERS_C, 2, C_GROUPS, C_STATE, C_GROUP), (2 * C_GROUP) ** -0.5),
        "c_b_im": nrm((N_LAYERS_C, 2, C_GROUPS, C_STATE, C_GROUP), (2 * C_GROUP) ** -0.5),
        "c_c_re": nrm((N_LAYERS_C, 2, C_GROUPS, C_GROUP, C_STATE), (2 * C_STATE) ** -0.5),
        "c_c_im": nrm((N_LAYERS_C, 2, C_GROUPS, C_GROUP, C_STATE), (2 * C_STATE) ** -0.5),
        "c_d": nrm((N_LAYERS_C, C_WIDTH), 1.0),
        "c_w_glu": nrm((N_LAYERS_C, C_WIDTH, 2 * D), C_WIDTH ** -0.5),
    }


def reference(x, c, ctx, c_ctx, w_ada, b_ada, norm_g, ffn_w_gu, ffn_w_down,
              a_w_in, a_v_gain, a_w_s, a_b_s, a_w_out,
              b_w_qkv, b_q_gain, b_k_gain, b_rpb, b_w_out,
              c_w_in, c_a_re, c_a_im, c_log_dt, c_b_re, c_b_im, c_c_re, c_c_im, c_d, c_w_glu):
    h, hc = x, ctx
    for i in range(DEPTH):
        kind = i % N_MIXERS
        j = i // N_MIXERS
        last = i == DEPTH - 1
        ctx_in = (not last) or kind != 0
        ctx_out = not last
        mod = _adaln(c, w_ada[i], b_ada[i])
        mod_c = _adaln(c_ctx[None], w_ada[i], b_ada[i])

        h = h + 0.5 * _sublayer_gate(mod, 0) * _swiglu(_sublayer_in(h, norm_g[i, 0], mod, 0),
                                                       ffn_w_gu[i, 0], ffn_w_down[i, 0])
        if ctx_in:
            hc = hc + 0.5 * _sublayer_gate(mod_c, 0) * _swiglu(_sublayer_in(hc, norm_g[i, 0], mod_c, 0),
                                                               ffn_w_gu[i, 0], ffn_w_down[i, 0])
        xin = _sublayer_in(h, norm_g[i, 1], mod, 1)
        if kind == 0:
            y = _chunk_gmlp(xin, a_w_in[j], a_v_gain[j], a_w_s[j], a_b_s[j], a_w_out[j])
            y_c = None
            if ctx_out:
                xin_c = _sublayer_in(hc, norm_g[i, 1], mod_c, 1)
                y_c = _chunk_gmlp(xin_c, a_w_in[j], a_v_gain[j], a_w_s[j], a_b_s[j], a_w_out[j])
        elif kind == 1:
            xin_c = _sublayer_in(hc, norm_g[i, 1], mod_c, 1)
            y, y_c = _neighbourhood_attention(xin, xin_c, b_w_qkv[j], b_q_gain[j], b_k_gain[j],
                                              b_rpb[j], b_w_out[j], ctx_out)
        else:
            xin_c = _sublayer_in(hc, norm_g[i, 1], mod_c, 1)
            y, y_c = _s5_mixer(xin, xin_c, c_w_in[j], c_a_re[j], c_a_im[j], c_log_dt[j],
                               c_b_re[j], c_b_im[j], c_c_re[j], c_c_im[j], c_d[j], c_w_glu[j], ctx_out)
        h = h + _sublayer_gate(mod, 1) * y
        h = h + 0.5 * _sublayer_gate(mod, 2) * _swiglu(_sublayer_in(h, norm_g[i, 2], mod, 2),
                                                       ffn_w_gu[i, 1], ffn_w_down[i, 1])
        if ctx_out:
            hc = hc + _sublayer_gate(mod_c, 1) * y_c
            hc = hc + 0.5 * _sublayer_gate(mod_c, 2) * _swiglu(_sublayer_in(hc, norm_g[i, 2], mod_c, 2),
                                                               ffn_w_gu[i, 1], ffn_w_down[i, 1])
    return h
```

```cpp
#include <hip/hip_runtime.h>
#include <cstdio>
#include <cstdint>
namespace pg8 {
#define PG8_LAS __attribute__((address_space(3)))
typedef unsigned short bf16_t;
typedef short bf16x8 __attribute__((ext_vector_type(8)));
typedef float f32x4 __attribute__((ext_vector_type(4)));
typedef unsigned u32x4 __attribute__((ext_vector_type(4)));
constexpr int BM = 256, BK = 64, HALF = 128, HTB = HALF * BK * 2  , STAGE_BYTES = 8 * HTB, NXCD = 8, WGM = 8;

__host__ __device__ __forceinline__ int lds_byte(int r, int c) { const int st = (r >> 4) * 2 + (c >> 5), rr = r & 15, cc = c & 31, ob = rr * 64 + cc * 2; return st * 1024 + (ob ^ (((ob >> 9) & 1) << 5)); }
__host__ __device__ __forceinline__ void stage_rc(int b, int& R, int& C) { const int st = b / 1024, sb = b % 1024, swz = sb ^ (((sb >> 9) & 1) << 5); R = (st >> 1) * 16 + swz / 64; C = (st & 1) * 32 + (swz % 64) / 2; }
__host__ __device__ __forceinline__ int perm32(int rho) { const int n = rho >> 4, i = rho & 15; return 8 * (i >> 2) + 4 * n + (i & 3); }

struct Unit { int pm, pn; };
struct Gemm { const bf16_t* A; const bf16_t* Bt; int M, N, K; };

struct StaticOrder {
    int nM, nN, nwg, G, c;
    __host__ __device__ void init(int M, int N, int G_, int c_) { nM = M / BM; nN = N / BM; nwg = nM * nN; G = G_; c = c_; }
    __host__ __device__ bool next(int i, Unit& u) const {
        const long L = (long)i * G + c; if (L >= nwg) return false;
        int wgid = (int)L; { const int q = nwg / NXCD, r = nwg % NXCD, xcd = wgid % NXCD, off = wgid / NXCD; wgid = (xcd < r ? xcd * (q + 1) : r * (q + 1) + (xcd - r) * q) + off; }
        const int nig = WGM * nN, gid = wgid / nig, fm = gid * WGM, gsz = (nM - fm) < WGM ? (nM - fm) : WGM;
        u.pm = fm + ((wgid % nig) % gsz); u.pn = (wgid % nig) / gsz; return true;
    }
    __device__ __forceinline__ void a_ready(const Unit&) const {}
    __device__ __forceinline__ void done(const Unit&) const {}
};
__device__ __forceinline__ unsigned cvt_pk_bf16(float lo, float hi) { unsigned r; asm volatile("v_cvt_pk_bf16_f32 %0, %1, %2" : "=v"(r) : "v"(lo), "v"(hi)); return r; }
__device__ __forceinline__ float fsigmoid(float x) { return __builtin_amdgcn_rcpf(1.0f + __builtin_amdgcn_exp2f(-1.44269504f * x)); }
__device__ __forceinline__ float fsilu(float x) { return x * fsigmoid(x); }
__device__ __forceinline__ float fgelu(float x) { return x * fsigmoid(1.5957691216f * (x + 0.044715f * x * x * x)); }
constexpr int ROWS_LAT = 8192, ROWS_ALL = 8704, MODW = 9 * 2048;

struct EpiSwiglu {
    static constexpr bool PERM = true, AFTER_DRAIN = false;
    bf16_t* O; int ldc;
    __device__ __forceinline__ void operator()(const f32x4 (&acc)[2][2][4][2], const Unit& u, int wr, int wc, int fr, int fq) const {
        const int row0 = u.pm * BM + wr * 64 + fr, col0 = u.pn * HALF + wc * 32 + 8 * fq;
#pragma unroll
        for (int ai = 0; ai < 2; ++ai)
#pragma unroll
            for (int m = 0; m < 4; ++m) { bf16_t* rowp = O + (size_t)(row0 + ai * HALF + m * 16) * ldc + col0;
                const f32x4 g0 = acc[ai][0][m][0], g1 = acc[ai][0][m][1], u0 = acc[ai][1][m][0], u1 = acc[ai][1][m][1];
                u32x4 w; w.x = cvt_pk_bf16(fsilu(g0[0]) * u0[0], fsilu(g0[1]) * u0[1]); w.y = cvt_pk_bf16(fsilu(g0[2]) * u0[2], fsilu(g0[3]) * u0[3]);
                w.z = cvt_pk_bf16(fsilu(g1[0]) * u1[0], fsilu(g1[1]) * u1[1]); w.w = cvt_pk_bf16(fsilu(g1[2]) * u1[2], fsilu(g1[3]) * u1[3]);
                *(u32x4*)rowp = w; }
    }
};
struct EpiRes {
    static constexpr bool PERM = false, AFTER_DRAIN = false;
    const float* blat; const float* bctx; float* olat; float* octx; const float* gate; float f;
    __device__ __forceinline__ void operator()(const f32x4 (&acc)[2][2][4][2], const Unit& u, int wr, int wc, int fr, int fq) const {
        const bool isctx = u.pm >= 32; const int cls = isctx ? 2 : (u.pm >> 4);
        const float* base = isctx ? bctx : blat; float* out = isctx ? octx : olat;
        const int row0 = (isctx ? u.pm - 32 : u.pm) * BM + wr * 64 + fr, col0 = u.pn * BM + wc * 32 + 4 * fq;
        const float* gp = gate + cls * MODW + col0;
        f32x4 gv[2][2];
#pragma unroll
        for (int bj = 0; bj < 2; ++bj)
#pragma unroll
            for (int n = 0; n < 2; ++n) gv[bj][n] = *(const f32x4*)(gp + bj * HALF + n * 16) * f;
#pragma unroll
        for (int ai = 0; ai < 2; ++ai)
#pragma unroll
            for (int m = 0; m < 4; ++m) { const size_t off = (size_t)(row0 + ai * HALF + m * 16) * 2048 + col0;
#pragma unroll
                for (int bj = 0; bj < 2; ++bj)
#pragma unroll
                    for (int n = 0; n < 2; ++n) { const f32x4 b = *(const f32x4*)(base + off + bj * HALF + n * 16); *(f32x4*)(out + off + bj * HALF + n * 16) = b + gv[bj][n] * acc[ai][bj][m][n]; } }
    }
};
struct EpiGluRes {
    static constexpr bool PERM = false, AFTER_DRAIN = false;
    const float* blat; const float* bctx; float* olat; float* octx; const float* gate;
    __device__ __forceinline__ void operator()(const f32x4 (&acc)[2][2][4][2], const Unit& u, int wr, int wc, int fr, int fq) const {
        const bool isctx = u.pm >= 32; const int cls = isctx ? 2 : (u.pm >> 4);
        const float* base = isctx ? bctx : blat; float* out = isctx ? octx : olat;
        const int row0 = (isctx ? u.pm - 32 : u.pm) * BM + wr * 64 + fr, col0 = u.pn * HALF + wc * 32 + 4 * fq;
        const float* gp = gate + cls * MODW + col0;
        f32x4 gv[2];
#pragma unroll
        for (int n = 0; n < 2; ++n) gv[n] = *(const f32x4*)(gp + n * 16);
#pragma unroll
        for (int ai = 0; ai < 2; ++ai)
#pragma unroll
            for (int m = 0; m < 4; ++m) { const size_t off = (size_t)(row0 + ai * HALF + m * 16) * 2048 + col0;
#pragma unroll
                for (int n = 0; n < 2; ++n) { const f32x4 b = *(const f32x4*)(base + off + n * 16); const f32x4 av = acc[ai][0][m][n], gg = acc[ai][1][m][n];
                    f32x4 v; v[0] = av[0] * fsigmoid(gg[0]); v[1] = av[1] * fsigmoid(gg[1]); v[2] = av[2] * fsigmoid(gg[2]); v[3] = av[3] * fsigmoid(gg[3]);
                    *(f32x4*)(out + off + n * 16) = b + gv[n] * v; } }
    }
};
template <int MODE> struct EpiBf {
    static constexpr bool PERM = true, AFTER_DRAIN = false;
    bf16_t* O; int ldc; float* ss;
    __device__ __forceinline__ void operator()(const f32x4 (&acc)[2][2][4][2], const Unit& u, int wr, int wc, int fr, int fq) const {
        const int row0 = u.pm * BM + wr * 64 + fr, col0 = u.pn * BM + wc * 32 + 8 * fq;
#pragma unroll
        for (int ai = 0; ai < 2; ++ai)
#pragma unroll
            for (int m = 0; m < 4; ++m) { const int row = row0 + ai * HALF + m * 16; bf16_t* rowp = O + (size_t)row * ldc + col0; float s1 = 0.f;
#pragma unroll
                for (int bj = 0; bj < 2; ++bj) { f32x4 v0 = acc[ai][bj][m][0], v1 = acc[ai][bj][m][1];
                    if (MODE == 1) {
#pragma unroll
                        for (int j = 0; j < 4; ++j) { v0[j] = fgelu(v0[j]); v1[j] = fgelu(v1[j]); } }
                    u32x4 w; w.x = cvt_pk_bf16(v0[0], v0[1]); w.y = cvt_pk_bf16(v0[2], v0[3]); w.z = cvt_pk_bf16(v1[0], v1[1]); w.w = cvt_pk_bf16(v1[2], v1[3]);
                    *(u32x4*)(rowp + bj * HALF) = w;
                    if (MODE != 0) { float s = (v0[0] * v0[0] + v0[1] * v0[1]) + (v0[2] * v0[2] + v0[3] * v0[3]) + (v1[0] * v1[0] + v1[1] * v1[1]) + (v1[2] * v1[2] + v1[3] * v1[3]);
                        if (MODE == 2) { if (u.pn < 16) { s += __shfl_xor(s, 16); s += __shfl_xor(s, 32); if (fq == 0) unsafeAtomicAdd(ss + (size_t)(2 * u.pn + bj) * ROWS_ALL + row, s); } }
                        else s1 += s; } }
                if (MODE == 1) { if (u.pn >= 8) { s1 += __shfl_xor(s1, 16); s1 += __shfl_xor(s1, 32); if (fq == 0) unsafeAtomicAdd(ss + row, s1); } } }
    }
};

template <class Epi, class Sched, bool ALIGN_EPI = false, bool SP2 = false>
__device__ __forceinline__ void gemm_phase(PG8_LAS unsigned char* lds, const Gemm g, const Sched& S, const Epi& E) {
    int tid_l = threadIdx.x; asm volatile("" : "+v"(tid_l));
    const int tid = tid_l, wid = __builtin_amdgcn_readfirstlane(tid >> 6), lane = tid & 63, wr = wid >> 2, wc = wid & 3, fr = lane & 15, fq = lane >> 4;
    const int K = g.K, nt = K / BK;
    unsigned voffA[2], voffB[2];
#pragma unroll
    for (int i = 0; i < 2; ++i) { int R, C; stage_rc(tid * 16 + i * 8192, R, C); const int Rb = Epi::PERM ? ((R & ~31) + perm32(R & 31)) : R;
        voffA[i] = (unsigned)(R * K + C) * 2u; voffB[i] = (unsigned)(Rb * K + C) * 2u; }
    const size_t kstep = (size_t)(BK * 2);
    const size_t hstep = (size_t)HALF * K * 2;
    const size_t tstep = 2 * hstep;
    const unsigned ldsw = (unsigned)wid * 1024u;
    const int aoff = lds_byte(wr * 64 + fr, fq * 8), boff = lds_byte(wc * 32 + fr, fq * 8);
#define PG8_SA(b, h) (((b) * 2 + (h)) * HTB)
#define PG8_SB(b, h) ((4 + (b) * 2 + (h)) * HTB)
#define PG8_STAGE(bufoff, gbase, voff) do { _Pragma("unroll") for (int _i = 0; _i < 2; ++_i) \
        __builtin_amdgcn_global_load_lds((const unsigned*)((const char*)(gbase) + (voff)[_i]), (PG8_LAS unsigned*)(lds + (bufoff) + ldsw + _i * 8192), 16, 0, 0); } while (0)
#define PG8_LDA(dst, b, h) do { _Pragma("unroll") for (int m = 0; m < 4; ++m) _Pragma("unroll") for (int k = 0; k < 2; ++k) dst[m][k] = *(const PG8_LAS bf16x8*)(lds + PG8_SA(b, h) + aoff + m * 2048 + k * 1024); } while (0)
#define PG8_LDB(dst, b, h) do { _Pragma("unroll") for (int n = 0; n < 2; ++n) _Pragma("unroll") for (int k = 0; k < 2; ++k) dst[n][k] = *(const PG8_LAS bf16x8*)(lds + PG8_SB(b, h) + boff + n * 2048 + k * 1024); } while (0)
#define PG8_MMA(ai, bj, At, Bt) do { __builtin_amdgcn_s_setprio(1); _Pragma("unroll") for (int m = 0; m < 4; ++m) _Pragma("unroll") for (int n = 0; n < 2; ++n) _Pragma("unroll") for (int k = 0; k < 2; ++k) \
        acc[ai][bj][m][n] = __builtin_amdgcn_mfma_f32_16x16x32_bf16(Bt[n][k], At[m][k], acc[ai][bj][m][n], 0, 0, 0); __builtin_amdgcn_s_setprio(0); } while (0)
#define PG8_WAIT_V(n) asm volatile("s_waitcnt vmcnt(" #n ")" ::: "memory")
#define PG8_WAIT_L(n) asm volatile("s_waitcnt lgkmcnt(" #n ")" ::: "memory")
#define PG8_BAR __builtin_amdgcn_s_barrier()
#define PG8_SCHED __builtin_amdgcn_sched_barrier(0)
    Unit cur, nxt; int ui = 0;
    if (!S.next(0, cur)) return;
    f32x4 acc[2][2][4][2];
#pragma unroll
    for (int a = 0; a < 2; ++a)
#pragma unroll
        for (int b = 0; b < 2; ++b)
#pragma unroll
            for (int m = 0; m < 4; ++m)
#pragma unroll
                for (int n = 0; n < 2; ++n) acc[a][b][m][n] = (f32x4){0.f, 0.f, 0.f, 0.f};
    bf16x8 At[4][2], B0[2][2], B1[2][2];
    const char* cA = (const char*)g.A + (size_t)cur.pm * tstep; const char* cB = (const char*)g.Bt + (size_t)cur.pn * tstep;
    S.a_ready(cur);
    if constexpr (SP2) {
        PG8_STAGE(PG8_SB(0, 0), cB, voffB); PG8_STAGE(PG8_SB(0, 1), cB + hstep, voffB); PG8_STAGE(PG8_SA(0, 0), cA, voffA); PG8_STAGE(PG8_SA(0, 1), cA + hstep, voffA);
        if (wr == 1) PG8_BAR;
        PG8_WAIT_V(2); PG8_BAR;
        PG8_STAGE(PG8_SB(1, 0), cB + kstep, voffB); PG8_STAGE(PG8_SA(1, 0), cA + kstep, voffA); PG8_STAGE(PG8_SB(1, 1), cB + hstep + kstep, voffB);
        PG8_WAIT_V(6); PG8_BAR;
    } else {
        PG8_STAGE(PG8_SB(0, 0), cB, voffB); PG8_STAGE(PG8_SA(0, 0), cA, voffA); PG8_STAGE(PG8_SB(0, 1), cB + hstep, voffB); PG8_STAGE(PG8_SA(0, 1), cA + hstep, voffA);
        if (wr == 1) PG8_BAR;
        PG8_WAIT_V(4); PG8_BAR;
        PG8_STAGE(PG8_SB(1, 0), cB + kstep, voffB); PG8_STAGE(PG8_SA(1, 0), cA + kstep, voffA); PG8_STAGE(PG8_SB(1, 1), cB + hstep + kstep, voffB);
        PG8_WAIT_V(6); PG8_BAR;
    }
    for (;;) {
        const bool has_next = S.next(ui + 1, nxt);
        const char* nA = has_next ? (const char*)g.A + (size_t)nxt.pm * tstep : cA; const char* nB = has_next ? (const char*)g.Bt + (size_t)nxt.pn * tstep : cB;
        for (int t = 0; t < nt; t += 2) {
            const bool last = (t == nt - 2);
            const char* a1 = cA + (size_t)(t + 1) * kstep;
            const char* a2 = last ? nA : cA + (size_t)(t + 2) * kstep; const char* b2 = last ? nB : cB + (size_t)(t + 2) * kstep;
            const char* a3 = a2 + kstep; const char* b3 = b2 + kstep;
            if (last && has_next) S.a_ready(nxt);
            if constexpr (SP2) {
            PG8_LDB(B0, 0, 0); PG8_LDB(B1, 0, 1); PG8_SCHED; PG8_LDA(At, 0, 0); PG8_STAGE(PG8_SA(1, 1), a1 + hstep, voffA);
            PG8_WAIT_V(8); PG8_WAIT_L(0); PG8_BAR; PG8_MMA(0, 0, At, B0); PG8_MMA(0, 1, At, B1); PG8_BAR; PG8_SCHED;
            PG8_LDA(At, 0, 1); PG8_STAGE(PG8_SB(0, 0), b2, voffB); PG8_STAGE(PG8_SB(0, 1), b2 + hstep, voffB); PG8_STAGE(PG8_SA(0, 0), a2, voffA);
            PG8_WAIT_V(8); PG8_WAIT_L(0); PG8_BAR; PG8_MMA(1, 0, At, B0); PG8_MMA(1, 1, At, B1); PG8_BAR; PG8_SCHED;
            PG8_LDB(B0, 1, 0); PG8_LDB(B1, 1, 1); PG8_SCHED; PG8_LDA(At, 1, 0); PG8_STAGE(PG8_SA(0, 1), a2 + hstep, voffA);
            PG8_WAIT_V(8); PG8_WAIT_L(0); PG8_BAR; PG8_MMA(0, 0, At, B0); PG8_MMA(0, 1, At, B1); PG8_BAR; PG8_SCHED;
            PG8_LDA(At, 1, 1); PG8_STAGE(PG8_SB(1, 0), b3, voffB); PG8_STAGE(PG8_SB(1, 1), b3 + hstep, voffB); PG8_STAGE(PG8_SA(1, 0), a3, voffA);
            PG8_WAIT_V(8); PG8_WAIT_L(0); PG8_BAR; PG8_MMA(1, 0, At, B0); PG8_MMA(1, 1, At, B1); PG8_BAR; PG8_SCHED;
            } else {
            PG8_LDB(B0, 0, 0); PG8_SCHED; PG8_LDA(At, 0, 0); PG8_STAGE(PG8_SA(1, 1), a1 + hstep, voffA);
            PG8_WAIT_L(8); PG8_BAR; PG8_WAIT_L(0); PG8_MMA(0, 0, At, B0); PG8_BAR; PG8_SCHED;
            PG8_LDB(B1, 0, 1); PG8_STAGE(PG8_SB(0, 0), b2, voffB);
            PG8_BAR; PG8_WAIT_L(0); PG8_MMA(0, 1, At, B1); PG8_BAR;
            PG8_LDA(At, 0, 1); PG8_STAGE(PG8_SA(0, 0), a2, voffA);
            PG8_BAR; PG8_WAIT_L(0); PG8_MMA(1, 0, At, B0); PG8_BAR; PG8_SCHED;
            PG8_STAGE(PG8_SB(0, 1), b2 + hstep, voffB);
            PG8_WAIT_V(6); PG8_BAR; PG8_MMA(1, 1, At, B1); PG8_BAR;
            PG8_LDB(B0, 1, 0); PG8_SCHED; PG8_LDA(At, 1, 0); PG8_STAGE(PG8_SA(0, 1), a2 + hstep, voffA);
            PG8_WAIT_L(8); PG8_BAR; PG8_WAIT_L(0); PG8_MMA(0, 0, At, B0); PG8_BAR; PG8_SCHED;
            PG8_LDB(B1, 1, 1); PG8_STAGE(PG8_SB(1, 0), b3, voffB);
            PG8_BAR; PG8_WAIT_L(0); PG8_MMA(0, 1, At, B1); PG8_BAR;
            PG8_LDA(At, 1, 1); PG8_STAGE(PG8_SA(1, 0), a3, voffA);
            PG8_BAR; PG8_WAIT_L(0); PG8_MMA(1, 0, At, B0); PG8_BAR; PG8_SCHED;
            PG8_STAGE(PG8_SB(1, 1), b3 + hstep, voffB);
            PG8_WAIT_V(6); PG8_BAR; PG8_MMA(1, 1, At, B1); PG8_BAR;
            }
        }
        if constexpr (ALIGN_EPI) { if (wr == 0) PG8_BAR; }
        if constexpr (!Epi::AFTER_DRAIN) { E(acc, cur, wr, wc, fr, fq); S.done(cur); }
        if (!has_next) break;
#pragma unroll
        for (int a = 0; a < 2; ++a)
#pragma unroll
            for (int b = 0; b < 2; ++b)
#pragma unroll
                for (int m = 0; m < 4; ++m)
#pragma unroll
                    for (int n = 0; n < 2; ++n) acc[a][b][m][n] = (f32x4){0.f, 0.f, 0.f, 0.f};
        cur = nxt; cA = nA; cB = nB; ++ui;
        if constexpr (ALIGN_EPI) { if (wr == 1) PG8_BAR; }
    }
    PG8_WAIT_V(0);
    if constexpr (!ALIGN_EPI) { if (wr == 0) PG8_BAR; }
    PG8_BAR;
    if constexpr (Epi::AFTER_DRAIN) { E.fused(acc, cur, wr, wc, fr, fq, lds, wid, lane); S.done(cur); }
#undef PG8_SA
#undef PG8_SB
#undef PG8_STAGE
#undef PG8_LDA
#undef PG8_LDB
#undef PG8_MMA
#undef PG8_WAIT_V
#undef PG8_WAIT_L
#undef PG8_BAR
#undef PG8_SCHED
}
}
#define XB_TMO      128
#define XB_XCNT(j)  (256  + 64 * (j))
#define XB_XSUB(j)  (1280 + 64 * (j))
#define XB_XGEN(j)  (2304 + 64 * (j))
#define XB_TOP      3328
#define XB_TOPGEN   3392
#define XCD_BAR_WORDS 3456
#define XB_SPIN_CAP (1u << 18)
#define LAS __attribute__((address_space(3)))

__device__ __forceinline__ unsigned xb_ld(unsigned* p)              { return __hip_atomic_load(p, __ATOMIC_RELAXED, __HIP_MEMORY_SCOPE_AGENT); }
__device__ __forceinline__ unsigned xb_add(unsigned* p, unsigned v) { return __hip_atomic_fetch_add(p, v, __ATOMIC_RELAXED, __HIP_MEMORY_SCOPE_AGENT); }
__device__ __forceinline__ unsigned xb_xcc_id() { return (unsigned)__builtin_amdgcn_s_getreg((3 << 11) | 20) & 0xFu; }
#define XB_SPIN(cond, bar) do { unsigned _sp = 0; while (cond) { __builtin_amdgcn_s_sleep(1); \
    if ((++_sp & 255u) == 0u) { if (xb_ld(&(bar)[XB_TMO])) break; if (_sp > XB_SPIN_CAP) { atomicAdd(&(bar)[XB_TMO], 1u); break; } } } } while (0)

struct XcdBarrier {
    unsigned* bar; unsigned x;
    volatile LAS unsigned* st;
};

__device__ __forceinline__ XcdBarrier xcd_barrier_post(unsigned* bar, volatile LAS unsigned* st) {
    XcdBarrier b; b.bar = bar; b.x = xb_xcc_id(); b.st = st;
    if (threadIdx.x == 0) (void)xb_add(&bar[XB_XCNT(b.x)], 1u);
    return b;
}
__device__ __forceinline__ void xcd_barrier_complete(unsigned* bar, unsigned x, unsigned& nloc, unsigned& nx) {
    const unsigned G = gridDim.x * gridDim.y * gridDim.z;
    unsigned sum, cnt, mine, sp = 0u;
    for (;;) {
        sum = 0u; cnt = 0u; mine = 0u;
#pragma unroll
        for (unsigned j = 0; j < 16; ++j) { const unsigned c = xb_ld(&bar[XB_XCNT(j)]); sum += c; cnt += (c > 0u) ? 1u : 0u; mine = (j == x) ? c : mine; }
        if (sum == G) break;
        __builtin_amdgcn_s_sleep(1);
        if ((++sp & 255u) == 0u) { if (xb_ld(&bar[XB_TMO])) break; if (sp > XB_SPIN_CAP) { atomicAdd(&bar[XB_TMO], 1u); break; } }
    }
    nloc = mine > 0u ? mine : 1u; nx = cnt > 0u ? cnt : 1u;
}

__device__ __forceinline__ void xcd_barrier(const XcdBarrier& b) {
    asm volatile("s_waitcnt vmcnt(0)" ::: "memory");
    __syncthreads();
    if (threadIdx.x == 0) {
        unsigned* bar = b.bar;
        __builtin_amdgcn_s_waitcnt(0);
        unsigned nloc = b.st[0], nx = b.st[1];
        if (nloc == 0u) { xcd_barrier_complete(bar, b.x, nloc, nx); b.st[0] = nloc; b.st[1] = nx; }
        const unsigned old = xb_add(&bar[XB_XSUB(b.x)], 1u);
        const unsigned gen = old / nloc;
        if (old + 1u == (gen + 1u) * nloc) {
            __builtin_amdgcn_fence(__ATOMIC_RELEASE, "agent");
            asm volatile("s_waitcnt vmcnt(0)" ::: "memory");
            const unsigned og = xb_add(&bar[XB_TOP], 1u);
            const unsigned tg = og / nx;
            if (og + 1u == (tg + 1u) * nx) xb_add(&bar[XB_TOPGEN], 1u);
            else XB_SPIN(xb_ld(&bar[XB_TOPGEN]) == tg, bar);
            __builtin_amdgcn_fence(__ATOMIC_ACQUIRE, "agent");
            xb_add(&bar[XB_XGEN(b.x)], 1u);
            asm volatile("s_waitcnt vmcnt(0)" ::: "memory");
        } else {
            XB_SPIN(xb_ld(&bar[XB_XGEN(b.x)]) == gen, bar);
            __builtin_amdgcn_fence(__ATOMIC_ACQUIRE, "agent");
            asm volatile("s_waitcnt vmcnt(0)" ::: "memory");
        }
    }
    __syncthreads();
}
#define GAS __attribute__((address_space(1)))
typedef unsigned short bf16;
typedef float v4f __attribute__((ext_vector_type(4)));
typedef float v2f __attribute__((ext_vector_type(2)));
typedef float v16f __attribute__((ext_vector_type(16)));
typedef short b8 __attribute__((ext_vector_type(8)));
typedef unsigned v4u __attribute__((ext_vector_type(4)));
typedef unsigned v2u __attribute__((ext_vector_type(2)));
#define LDS_WAIT() asm volatile("s_waitcnt lgkmcnt(0)" ::: "memory")
#define MFMA32(a, b, c) __builtin_amdgcn_mfma_f32_32x32x16_bf16((a), (b), (c), 0, 0, 0)
#define MFMA16(a, b, c) __builtin_amdgcn_mfma_f32_16x16x32_bf16((a), (b), (c), 0, 0, 0)

using pg8::MODW;
constexpr int NWAVES = 8, NTHR = 512;
constexpr int D = 2048, DFF = 5632, ML = 8192, MC = 512, MT = 8704;
constexpr float RMS_EPS = 1e-6f;
#ifndef MK_ONE_LAUNCH
#define MK_ONE_LAUNCH 0
#endif
constexpr int NPHASES = 42;
#ifndef NO_ATTN
#define NO_ATTN 0
#endif
#ifndef NO_SCAN
#define NO_SCAN 0
#endif
#ifndef NO_SPAT
#define NO_SPAT 0
#endif
#ifndef NO_P0
#define NO_P0 0
#endif

constexpr size_t MiB = 1u << 20;
constexpr size_t WS_CTL = 0;
constexpr size_t WS_VSS = 1 * MiB;
constexpr size_t WS_QKSS = 1 * MiB + 128 * 1024;
constexpr size_t WS_MOD = 3 * MiB;
constexpr size_t ZERO_BYTES = 4 * MiB;
constexpr size_t WS_HC = 4 * MiB;
constexpr size_t WS_XN = 8 * MiB;
constexpr size_t WS_ACT = 42 * MiB;
constexpr size_t WS_Y = 144 * MiB;
constexpr size_t WS_WGU = 280 * MiB, WS_WDN = 632 * MiB, WS_AWIN = 808 * MiB, WS_AWOUT = 840 * MiB, WS_AWS = 856 * MiB;
constexpr size_t WS_BQKV = 857 * MiB, WS_BWO = 881 * MiB, WS_CWIN = 889 * MiB, WS_CGLU = 897 * MiB, WS_END = 913 * MiB;
constexpr int CW_BAR = 4096, BAR_STRIDE = 3584;
static_assert((CW_BAR + 48 * BAR_STRIDE) * 4 <= (int)MiB, "ctl");
constexpr int LDS_BYTES = 147456;
constexpr int MISC_OFF = 131072 + 320;

__device__ __forceinline__ float bf2f(unsigned short b) { return __uint_as_float(((unsigned)b) << 16); }
__device__ __forceinline__ unsigned pk_bf16(float lo, float hi) { return pg8::cvt_pk_bf16(lo, hi); }
__device__ __forceinline__ unsigned pk_bf16_m(float lo, float hi) { unsigned r; asm volatile("v_cvt_pk_bf16_f32 %0, %1, %2\n\ts_nop 1" : "=v"(r) : "v"(lo), "v"(hi)); return r; }
__device__ __forceinline__ float wave_sum(float v) {
#pragma unroll
    for (int o = 1; o < 64; o <<= 1) v += __shfl_xor(v, o);
    return v;
}

#define OPAQUE_V(x) asm volatile("" : "+v"(x))
struct Args { const float* in[29]; float* out; unsigned char* ws; int ph_lo, ph_hi, li, pad; };

__device__ __forceinline__ void tr_item(const float* W, int K, int N, bf16* WT, int nh, int item, LAS float* scr, int lane) {
    const int nblk = N / 32, kb = item / nblk, nb = item - kb * nblk, k0 = 64 * kb, n0 = 32 * nb;
    int drow0 = n0; if (nh) { const int half = n0 >= nh ? 1 : 0, c = n0 - half * nh; drow0 = 256 * (c >> 7) + 128 * half + (c & 127); }
    const float* src = W + (size_t)k0 * N + n0 + (lane & 31) + (size_t)(lane >> 5) * N;
#pragma unroll 8
    for (int i = 0; i < 32; ++i) scr[(2 * i + (lane >> 5)) * 33 + (lane & 31)] = src[(size_t)(2 * i) * N];
    LDS_WAIT(); asm volatile("" ::: "memory");
    const int c = lane & 7;
#pragma unroll
    for (int j = 0; j < 4; ++j) { const int n = (lane >> 3) + 8 * j; const LAS float* s = scr + (8 * c) * 33 + n;
        v4u o; o.x = pk_bf16(s[0 * 33], s[1 * 33]); o.y = pk_bf16(s[2 * 33], s[3 * 33]); o.z = pk_bf16(s[4 * 33], s[5 * 33]); o.w = pk_bf16(s[6 * 33], s[7 * 33]);
        *(v4u*)(WT + (size_t)(drow0 + n) * K + k0 + 8 * c) = o; }
    LDS_WAIT(); asm volatile("" ::: "memory");
}
__device__ __forceinline__ void p0_prologue(const Args& a, LAS unsigned char* lds, int gw, int NGW, int tid, int lane, int wave) {
    OPAQUE_V(tid); OPAQUE_V(lane);
    LAS float* sl = (LAS float*)(lds + 73728);
    for (int i = tid; i < 3 * 2048; i += NTHR) { const float v = i < 4096 ? a.in[1][i] : a.in[3][i - 4096]; sl[i] = v / (1.0f + __expf(-v)); }
    __syncthreads();
    LAS float* scr = (LAS float*)(lds + wave * 8704);
    unsigned char* ws = a.ws;
    constexpr int I_ADA = 4 * 72 * 16, I_GU = 32 * 352, I_DN = 88 * 64, I_AIN = 32 * 128, I_SQ = 32 * 64, I_QKV = 32 * 192, I_WS = 256;
    constexpr int NITEMS = I_ADA + 8 * I_GU + 8 * I_DN + 2 * I_AIN + 2 * I_SQ + I_QKV + I_SQ + I_SQ + I_AIN + I_WS;
    for (int it = gw; it < NITEMS; it += NGW) {
        int r = it;
        if (r < I_ADA) {
            const int layer = r / 1152, rr = r - layer * 1152, cb = rr >> 4, ks = rr & 15, n0 = cb * 256 + lane * 4, k0 = ks * 128;
            const float* Wp = a.in[4] + (size_t)layer * 2048 * MODW + (size_t)k0 * MODW + n0;
            v4f a0 = {0.f, 0.f, 0.f, 0.f}, a1 = a0, a2 = a0;
#pragma unroll 8
            for (int k = 0; k < 128; ++k) { const v4f w = *(const v4f*)(Wp + (size_t)k * MODW); a0 += w * sl[k0 + k]; a1 += w * sl[2048 + k0 + k]; a2 += w * sl[4096 + k0 + k]; }
            if (ks == 0) { const v4f bv = *(const v4f*)(a.in[5] + (size_t)layer * MODW + n0); a0 += bv; a1 += bv; a2 += bv; }
            float* mp = (float*)(ws + WS_MOD) + (size_t)layer * 3 * MODW + n0;
#pragma unroll
            for (int j = 0; j < 4; ++j) { unsafeAtomicAdd(mp + j, a0[j]); unsafeAtomicAdd(mp + MODW + j, a1[j]); unsafeAtomicAdd(mp + 2 * MODW + j, a2[j]); }
            continue; }
        r -= I_ADA;
        if (r < 8 * I_GU) { const int f = r / I_GU; tr_item(a.in[7] + (size_t)f * 2048 * 11264, 2048, 11264, (bf16*)(ws + WS_WGU) + (size_t)f * 11264 * 2048, 5632, r - f * I_GU, scr, lane); continue; } r -= 8 * I_GU;
        if (r < 8 * I_DN) { const int f = r / I_DN; tr_item(a.in[8] + (size_t)f * 5632 * 2048, 5632, 2048, (bf16*)(ws + WS_WDN) + (size_t)f * 2048 * 5632, 0, r - f * I_DN, scr, lane); continue; } r -= 8 * I_DN;
        if (r < 2 * I_AIN) { const int j = r / I_AIN; tr_item(a.in[9] + (size_t)j * 2048 * 4096, 2048, 4096, (bf16*)(ws + WS_AWIN) + (size_t)j * 4096 * 2048, 0, r - j * I_AIN, scr, lane); continue; } r -= 2 * I_AIN;
        if (r < 2 * I_SQ) { const int j = r / I_SQ; tr_item(a.in[13] + (size_t)j * 2048 * 2048, 2048, 2048, (bf16*)(ws + WS_AWOUT) + (size_t)j * 2048 * 2048, 0, r - j * I_SQ, scr, lane); continue; } r -= 2 * I_SQ;
        if (r < I_QKV) { tr_item(a.in[14], 2048, 6144, (bf16*)(ws + WS_BQKV), 0, r, scr, lane); continue; } r -= I_QKV;
        if (r < I_SQ) { tr_item(a.in[18], 2048, 2048, (bf16*)(ws + WS_BWO), 0, r, scr, lane); continue; } r -= I_SQ;
        if (r < I_SQ) { tr_item(a.in[19], 2048, 2048, (bf16*)(ws + WS_CWIN), 0, r, scr, lane); continue; } r -= I_SQ;
        if (r < I_AIN) { tr_item(a.in[28], 2048, 4096, (bf16*)(ws + WS_CGLU), 2048, r, scr, lane); continue; } r -= I_AIN;
        { const float* s = a.in[11] + (size_t)r * 2048 + lane * 4; bf16* d = (bf16*)(ws + WS_AWS) + (size_t)r * 2048 + lane * 4;
#pragma unroll
          for (int j = 0; j < 8; ++j) { const v4f v = *(const v4f*)(s + 256 * j); v2u o; o.x = pk_bf16(v[0], v[1]); o.y = pk_bf16(v[2], v[3]); *(v2u*)(d + 256 * j) = o; } }
    }
}

__device__ __forceinline__ void norm_phase(const float* hlat, const float* hctx, const float* gain, const float* modl, int s, bf16* xn, int M, int gw, int NGW, int lane) {
    OPAQUE_V(lane);
    for (int row = gw; row < M; row += NGW) {
        const bool isctx = row >= ML; const int cls = isctx ? 2 : (row >> 12);
        const v4f* xr = (const v4f*)(isctx ? hctx + (size_t)(row - ML) * D : hlat + (size_t)row * D) + lane;
        const v4f* sh = (const v4f*)(modl + cls * MODW + (3 * s) * D) + lane; const v4f* sc = sh + D / 4; const v4f* gn = (const v4f*)gain + lane;
        v4f v[8]; float ss = 0.f;
#pragma unroll
        for (int j = 0; j < 8; ++j) { v[j] = xr[64 * j]; ss += (v[j][0] * v[j][0] + v[j][1] * v[j][1]) + (v[j][2] * v[j][2] + v[j][3] * v[j][3]); }
        const float r = rsqrtf(wave_sum(ss) * (1.0f / D) + RMS_EPS);
        v2u* o = (v2u*)(xn + (size_t)row * D) + lane;
#pragma unroll
        for (int j = 0; j < 8; ++j) { const v4f y = v[j] * r * gn[64 * j] * (sc[64 * j] + 1.0f) + sh[64 * j]; v2u w; w.x = pk_bf16(y[0], y[1]); w.y = pk_bf16(y[2], y[3]); o[64 * j] = w; }
    }
}

__device__ __forceinline__ void spatial_phase(const bf16* uv, const float* vss, const bf16* wsb, const float* vgain, const float* bsg, bf16* su, int nchunk,
                                              LAS unsigned char* lds, int vcu, int G, int tid, int lane, int wave) {
    OPAQUE_V(tid); OPAQUE_V(lane);
    LAS float* rq = (LAS float*)lds;
    const int h = lane >> 5, r32 = lane & 31, cb = wave & 3, pb0 = (wave >> 2) * 2;
    for (int unit = vcu; unit < nchunk * 16; unit += G) {
        const int ch = unit >> 4, g = unit & 15, row0 = ch * 128;
        __syncthreads();
        if (tid < 128) rq[tid] = rsqrtf(vss[row0 + tid] * (1.0f / D) + RMS_EPS);
        __syncthreads();
        const bf16* vp = uv + (size_t)row0 * 4096 + 2048 + 128 * g + 32 * cb + r32;
        b8 Af[8];
#pragma unroll
        for (int s = 0; s < 8; ++s) { float x[8];
#pragma unroll
            for (int j = 0; j < 8; ++j) { const int q = 16 * s + 8 * h + j; x[j] = bf2f(vp[(size_t)q * 4096]) * rq[q]; }
            v4u w; w.x = pk_bf16_m(x[0], x[1]); w.y = pk_bf16_m(x[2], x[3]); w.z = pk_bf16_m(x[4], x[5]); w.w = pk_bf16_m(x[6], x[7]); Af[s] = __builtin_bit_cast(b8, w); }
        v16f acc[2];
#pragma unroll
        for (int pbi = 0; pbi < 2; ++pbi) {
#pragma unroll
            for (int i = 0; i < 16; ++i) acc[pbi][i] = 0.f;
            const bf16* wp = wsb + ((size_t)g * 128 + 32 * (pb0 + pbi) + r32) * 128 + 8 * h;
#pragma unroll
            for (int s = 0; s < 8; ++s) { const b8 Bf = *(const b8*)(wp + 16 * s); acc[pbi] = MFMA32(Af[s], Bf, acc[pbi]); } }
#pragma unroll
        for (int pbi = 0; pbi < 2; ++pbi) { const int p = 32 * (pb0 + pbi) + r32; const float bsp = bsg[g * 128 + p]; const size_t row = (size_t)(row0 + p);
#pragma unroll
            for (int i4 = 0; i4 < 4; ++i4) { const int cc = 128 * g + 32 * cb + 8 * i4 + 4 * h; const v4f vg = *(const v4f*)(vgain + cc);
                const v2u uu = *(const v2u*)(uv + row * 4096 + cc);
                const float u0 = __uint_as_float(uu.x << 16), u1 = __uint_as_float(uu.x & 0xffff0000u), u2 = __uint_as_float(uu.y << 16), u3 = __uint_as_float(uu.y & 0xffff0000u);
                v2u w; w.x = pk_bf16(u0 * (acc[pbi][4 * i4 + 0] * vg[0] + bsp), u1 * (acc[pbi][4 * i4 + 1] * vg[1] + bsp)); w.y = pk_bf16(u2 * (acc[pbi][4 * i4 + 2] * vg[2] + bsp), u3 * (acc[pbi][4 * i4 + 3] * vg[3] + bsp));
                *(v2u*)(su + row * D + cc) = w; } }
    }
}

__device__ __forceinline__ void attn_phase(const bf16* qkv, const float* qkss, const float* qgain, const float* kgain, const float* rpb, bf16* o, int gw, int NGW, int lane) {
    OPAQUE_V(lane);
    const int h = lane >> 5, r32 = lane & 31;
    constexpr int NU_LAT = 2 * 16 * 64 * 2, NU_CTX = 2 * 16 * 8;
    for (int wu = gw; wu < NU_LAT + NU_CTX; wu += NGW) {
        const bool lat = wu < NU_LAT;
        int b, hd, qrow, r = 0, qh = 0, rstart = 0;
        if (lat) { qh = wu & 1; r = (wu >> 1) & 63; hd = (wu >> 7) & 15; b = wu >> 11; qrow = b * 4096 + r * 64 + 32 * qh + r32; rstart = r - 4 < 0 ? 0 : (r - 4 > 56 ? 56 : r - 4); }
        else { const int w = wu - NU_LAT; hd = (w >> 3) & 15; b = w >> 7; qrow = ML + b * 256 + 32 * (w & 7) + r32; }
        const float rqv = rsqrtf(qkss[(size_t)hd * MT + qrow] * (1.0f / 128.0f) + RMS_EPS) * 0.08838834764831845f;
        const bf16* qp = qkv + (size_t)qrow * 6144 + 128 * hd + 8 * h;
        b8 Qf[8];
#pragma unroll
        for (int s = 0; s < 8; ++s) { const v4u raw = *(const v4u*)(qp + 16 * s); const int d0 = 16 * s + 8 * h;
            const v4f g0 = *(const v4f*)(qgain + d0), g1 = *(const v4f*)(qgain + d0 + 4), k0 = *(const v4f*)(kgain + d0), k1 = *(const v4f*)(kgain + d0 + 4);
            v4u w;
            w.x = pk_bf16_m(__uint_as_float(raw.x << 16) * rqv * g0[0] * k0[0], __uint_as_float(raw.x & 0xffff0000u) * rqv * g0[1] * k0[1]);
            w.y = pk_bf16_m(__uint_as_float(raw.y << 16) * rqv * g0[2] * k0[2], __uint_as_float(raw.y & 0xffff0000u) * rqv * g0[3] * k0[3]);
            w.z = pk_bf16_m(__uint_as_float(raw.z << 16) * rqv * g1[0] * k1[0], __uint_as_float(raw.z & 0xffff0000u) * rqv * g1[1] * k1[1]);
            w.w = pk_bf16_m(__uint_as_float(raw.w << 16) * rqv * g1[2] * k1[2], __uint_as_float(raw.w & 0xffff0000u) * rqv * g1[3] * k1[3]);
            Qf[s] = __builtin_bit_cast(b8, w); }
        v16f Oacc[4];
#pragma unroll
        for (int db = 0; db < 4; ++db)
#pragma unroll
            for (int i = 0; i < 16; ++i) Oacc[db][i] = 0.f;
        float lsum = 0.f;
        const int ntile = lat ? 24 : 8, qc = 32 * qh + r32, cstart = qc - 8 < 0 ? 0 : (qc - 8 > 48 ? 48 : qc - 8);
        for (int kt = 0; kt < ntile; ++kt) {
            const bool win = lat && kt < 16;
            const int krow0 = win ? b * 4096 + 64 * rstart + 32 * kt : ML + b * 256 + 32 * (lat ? kt - 16 : kt);
            const bf16* kp = qkv + (size_t)(krow0 + r32) * 6144 + 2048 + 128 * hd + 8 * h;
            v16f sacc;
#pragma unroll
            for (int i = 0; i < 16; ++i) sacc[i] = 0.f;
#pragma unroll
            for (int s = 0; s < 8; ++s) { const b8 Kf = *(const b8*)(kp + 16 * s); sacc = MFMA32(Kf, Qf[s], sacc); }
            const float* rkp = qkss + (size_t)(16 + hd) * MT + krow0 + 4 * h;
            const float* bp = rpb + (size_t)(hd * 15 + (rstart + (kt >> 1) - r + 7)) * 31 + 15 - qc + 32 * (kt & 1);
            float p[16];
#pragma unroll
            for (int i4 = 0; i4 < 4; ++i4) { const v4f rk = *(const v4f*)(rkp + 8 * i4);
#pragma unroll
                for (int j = 0; j < 4; ++j) { const int key = 8 * i4 + 4 * h + j; const float sc = sacc[4 * i4 + j] * rsqrtf(rk[j] * (1.0f / 128.0f) + RMS_EPS);
                    float pv;
                    if (win) { const int kc = 32 * (kt & 1) + key; const bool valid = (unsigned)(kc - cstart) < 16u; const float bias = valid ? bp[key] : 0.f; pv = valid ? __expf(sc + bias) : 0.f; }
                    else pv = __expf(sc);
                    p[4 * i4 + j] = pv; lsum += pv; } }
            const bf16* vp = qkv + (size_t)krow0 * 6144 + 4096 + 128 * hd + r32;
#pragma unroll
            for (int s2 = 0; s2 < 2; ++s2) {
                v4u pw; pw.x = pk_bf16_m(p[8 * s2 + 0], p[8 * s2 + 1]); pw.y = pk_bf16_m(p[8 * s2 + 2], p[8 * s2 + 3]); pw.z = pk_bf16_m(p[8 * s2 + 4], p[8 * s2 + 5]); pw.w = pk_bf16_m(p[8 * s2 + 6], p[8 * s2 + 7]);
                const b8 Pf = __builtin_bit_cast(b8, pw);
#pragma unroll
                for (int db = 0; db < 4; ++db) { b8 Vf;
#pragma unroll
                    for (int j = 0; j < 8; ++j) { const int key = 16 * s2 + 8 * (j >> 2) + 4 * h + (j & 3); Vf[j] = (short)vp[(size_t)key * 6144 + 32 * db]; }
                    Oacc[db] = MFMA32(Vf, Pf, Oacc[db]); } }
        }
        lsum += __shfl_xor(lsum, 32);
        const float inv = 1.0f / lsum;
        bf16* op = o + (size_t)qrow * D + 128 * hd + 4 * h;
#pragma unroll
        for (int db = 0; db < 4; ++db)
#pragma unroll
            for (int i4 = 0; i4 < 4; ++i4) { v2u w; w.x = pk_bf16(Oacc[db][4 * i4 + 0] * inv, Oacc[db][4 * i4 + 1] * inv); w.y = pk_bf16(Oacc[db][4 * i4 + 2] * inv, Oacc[db][4 * i4 + 3] * inv);
                *(v2u*)(op + 32 * db + 8 * i4) = w; }
    }
}

__device__ __forceinline__ void scan_phase(const bf16* ub, const float* a_re, const float* a_im, const float* log_dt, const float* b_re, const float* b_im, const float* c_re, const float* c_im,
                                           float* ybuf, LAS unsigned char* lds, int blk, int G, int wave, int lane) {
    OPAQUE_V(lane);
    if (wave >= 2) return;
    LAS float* BU = (LAS float*)(lds + wave * 32768);
    LAS unsigned char* HS = lds + wave * 32768 + 16384;
    LAS unsigned short* BB = (LAS unsigned short*)(lds + wave * 32768 + 16384 + 8704);
    const int h = lane >> 5, r32 = lane & 31, p = lane, ch = lane & 15, l4 = lane >> 4;
    for (int chain = blk * 2 + wave; chain < 512; chain += 2 * G) {
        const int dir = chain & 1, g = (chain >> 1) & 127, b = chain >> 8, dg = dir * 128 + g;
        const float lr = a_re[(size_t)dg * 64 + p], li = a_im[(size_t)dg * 64 + p], dt = expf(log_dt[dg]);
        const float er = expf(lr * dt), ar = er * cosf(li * dt), ai = er * sinf(li * dt);
        { const float nr = ar - 1.0f, ni = ai, den = 1.0f / (lr * lr + li * li), cr = (nr * lr + ni * li) * den, ci = (ni * lr - nr * li) * den;
          const float* brp = b_re + ((size_t)dg * 64 + p) * 16; const float* bip = b_im + ((size_t)dg * 64 + p) * 16;
#pragma unroll
          for (int c4 = 0; c4 < 4; ++c4) { const v4f br = *(const v4f*)(brp + 4 * c4), bi = *(const v4f*)(bip + 4 * c4);
              v2u wr_, wi_; wr_.x = pk_bf16(cr * br[0] - ci * bi[0], cr * br[1] - ci * bi[1]); wr_.y = pk_bf16(cr * br[2] - ci * bi[2], cr * br[3] - ci * bi[3]);
              wi_.x = pk_bf16(cr * bi[0] + ci * br[0], cr * bi[1] + ci * br[1]); wi_.y = pk_bf16(cr * bi[2] + ci * br[2], cr * bi[3] + ci * br[3]);
              *(LAS v2u*)(BB + (p * 2 + 0) * 16 + 4 * c4) = wr_; *(LAS v2u*)(BB + (p * 2 + 1) * 16 + 4 * c4) = wi_; } }
        LDS_WAIT(); asm volatile("" ::: "memory");
        b8 Bf[4];
#pragma unroll
        for (int cb = 0; cb < 4; ++cb) Bf[cb] = *(const LAS b8*)(BB + ((16 * cb + (r32 >> 1)) * 2 + (r32 & 1)) * 16 + 8 * h);
        b8 Cf[4];
#pragma unroll
        for (int ks = 0; ks < 4; ++ks) { const v4f cre = *(const v4f*)(c_re + ((size_t)dg * 16 + ch) * 64 + 16 * ks + 4 * l4), cim = *(const v4f*)(c_im + ((size_t)dg * 16 + ch) * 64 + 16 * ks + 4 * l4);
            v4u w; w.x = pk_bf16_m(cre[0], -cim[0]); w.y = pk_bf16_m(cre[1], -cim[1]); w.z = pk_bf16_m(cre[2], -cim[2]); w.w = pk_bf16_m(cre[3], -cim[3]); Cf[ks] = __builtin_bit_cast(b8, w); }
        float hr = 0.f, hi = 0.f;
        for (int bi_ = 0; bi_ < 136; ++bi_) {
            int rb, sg;
            if (dir == 0) { rb = bi_ < 8 ? ML + b * 256 + 32 * bi_ : b * 4096 + 32 * (bi_ - 8); sg = 1; }
            else { rb = bi_ < 8 ? ML + b * 256 + 255 - 32 * bi_ : b * 4096 + 4095 - 32 * (bi_ - 8); sg = -1; }
            const b8 Uf = *(const b8*)(ub + (size_t)(rb + sg * r32) * D + 16 * g + 8 * h);
#pragma unroll
            for (int cb = 0; cb < 4; ++cb) { v16f z;
#pragma unroll
                for (int i = 0; i < 16; ++i) z[i] = 0.f;
                const v16f dacc = MFMA32(Uf, Bf[cb], z);
#pragma unroll
                for (int i = 0; i < 16; ++i) BU[((i & 3) + 8 * (i >> 2) + 4 * h) * 128 + 32 * cb + r32] = dacc[i]; }
            LDS_WAIT(); asm volatile("" ::: "memory");
            v2f bu[32];
#pragma unroll
            for (int i = 0; i < 32; ++i) bu[i] = *(const LAS v2f*)(BU + i * 128 + 2 * p);
#pragma unroll
            for (int i = 0; i < 32; ++i) { const float nr = ar * hr - ai * hi + bu[i][0], ni = ar * hi + ai * hr + bu[i][1]; hr = nr; hi = ni;
                *(LAS unsigned*)(HS + i * 272 + 4 * p) = pk_bf16(hr, hi); }
            LDS_WAIT(); asm volatile("" ::: "memory");
#pragma unroll
            for (int tb = 0; tb < 2; ++tb) { v4f ya = {0.f, 0.f, 0.f, 0.f};
#pragma unroll
                for (int ks = 0; ks < 4; ++ks) { const b8 Hf = *(const LAS b8*)(HS + (16 * tb + ch) * 272 + (32 * ks + 8 * l4) * 2); ya = MFMA16(Cf[ks], Hf, ya); }
                const int row = rb + sg * (16 * tb + ch);
                *(v4f*)(ybuf + ((size_t)dir * MT + row) * D + 16 * g + 4 * l4) = ya; }
        }
    }
}
__device__ __forceinline__ void s5post_phase(const bf16* ub, const float* ybuf, const float* cd, bf16* xg, int M, int gw, int NGW, int lane) {
    OPAQUE_V(lane);
    for (int row = gw; row < M; row += NGW) {
        const v2u* up = (const v2u*)(ub + (size_t)row * D) + lane; const v4f* yf = (const v4f*)(ybuf + (size_t)row * D) + lane; const v4f* yr = (const v4f*)(ybuf + ((size_t)MT + row) * D) + lane;
        const v4f* dp = (const v4f*)cd + lane; v2u* o = (v2u*)(xg + (size_t)row * D) + lane;
#pragma unroll
        for (int j = 0; j < 8; ++j) { const v2u uu = up[64 * j]; const v4f d = dp[64 * j], a = yf[64 * j], c = yr[64 * j];
            const float y0 = d[0] * __uint_as_float(uu.x << 16) + a[0] + c[0], y1 = d[1] * __uint_as_float(uu.x & 0xffff0000u) + a[1] + c[1];
            const float y2 = d[2] * __uint_as_float(uu.y << 16) + a[2] + c[2], y3 = d[3] * __uint_as_float(uu.y & 0xffff0000u) + a[3] + c[3];
            v2u w; w.x = pk_bf16(pg8::fgelu(y0), pg8::fgelu(y1)); w.y = pk_bf16(pg8::fgelu(y2), pg8::fgelu(y3)); o[64 * j] = w; }
    }
}

__global__ void __launch_bounds__(NTHR, 2) fwd_kernel(Args a) {
    extern __shared__ __attribute__((aligned(16))) unsigned char lds_raw[];
    LAS unsigned char* lds = (LAS unsigned char*)lds_raw;
    volatile LAS unsigned* MISC = (volatile LAS unsigned*)(lds + MISC_OFF);
    const int tid = threadIdx.x, lane = tid & 63, wave = __builtin_amdgcn_readfirstlane(tid >> 6);
    const int G = gridDim.x, bx = blockIdx.x, vcu = (G % 8 == 0) ? (bx % 8) * (G / 8) + bx / 8 : bx;
    const int gw = vcu * NWAVES + wave, NGW = G * NWAVES;
    for (int u = tid; u < (LDS_BYTES - 131072) / 4; u += NTHR) ((LAS unsigned*)(lds + 131072))[u] = 0u;
    __syncthreads();
    unsigned char* ws = a.ws;
    XcdBarrier bar = xcd_barrier_post((unsigned*)(ws + WS_CTL) + CW_BAR + a.li * BAR_STRIDE, MISC + 8);
    const int lo = a.ph_lo, hi = a.ph_hi;
    int pc = 0;
#define PH_IN (lo <= pc && pc < hi)
#define PH_END() do { if (pc + 1 < hi) xcd_barrier(bar); } while (0)
    float* mod = (float*)(ws + WS_MOD); float* hc = (float*)(ws + WS_HC);
    bf16* xn = (bf16*)(ws + WS_XN); bf16* act = (bf16*)(ws + WS_ACT); float* ybuf = (float*)(ws + WS_Y);
    float* vss = (float*)(ws + WS_VSS); float* qkss = (float*)(ws + WS_QKSS);

    if (PH_IN) { if (!NO_P0) p0_prologue(a, lds, gw, NGW, tid, lane, wave); PH_END(); } ++pc;

    for (int f = 0; f < 8; ++f) {
        const int layer = f >> 1, sub = f & 1, kind = layer % 3, M = (layer == 3) ? ML : MT;
        const float* modl = mod + (size_t)layer * 3 * MODW;
        const float* hin_l = (f == 0) ? a.in[0] : (const float*)a.out; const float* hin_c = (f == 0) ? a.in[2] : (const float*)hc;
        if (PH_IN) { norm_phase(hin_l, hin_c, a.in[6] + (size_t)(layer * 3 + 2 * sub) * D, modl, 2 * sub, xn, M, gw, NGW, lane); PH_END(); } ++pc;
        if (PH_IN) { pg8::Gemm g{xn, (const bf16*)(ws + WS_WGU) + (size_t)f * 11264 * 2048, M, 11264, 2048}; pg8::StaticOrder S; S.init(M, 11264, G, bx);
            pg8::EpiSwiglu E{act, DFF}; pg8::gemm_phase<pg8::EpiSwiglu, pg8::StaticOrder, true, true>(lds, g, S, E); PH_END(); } ++pc;
        if (PH_IN) { pg8::Gemm g{act, (const bf16*)(ws + WS_WDN) + (size_t)f * 2048 * 5632, M, 2048, DFF}; pg8::StaticOrder S; S.init(M, 2048, G, bx);
            pg8::EpiRes E{hin_l, hin_c, a.out, hc, modl + (6 * sub + 2) * D, 0.5f}; pg8::gemm_phase<pg8::EpiRes, pg8::StaticOrder, true, true>(lds, g, S, E); PH_END(); } ++pc;
        if (sub == 0) {
            const int j = layer / 3;
            if (PH_IN) { norm_phase(a.out, hc, a.in[6] + (size_t)(layer * 3 + 1) * D, modl, 1, xn, M, gw, NGW, lane); PH_END(); } ++pc;
            if (kind == 0) {
                if (PH_IN) { pg8::Gemm g{xn, (const bf16*)(ws + WS_AWIN) + (size_t)j * 4096 * 2048, M, 4096, 2048}; pg8::StaticOrder S; S.init(M, 4096, G, bx);
                    pg8::EpiBf<1> E{act, 4096, vss + (size_t)j * MT}; pg8::gemm_phase<pg8::EpiBf<1>, pg8::StaticOrder, true, true>(lds, g, S, E); PH_END(); } ++pc;
                if (PH_IN) { if (!NO_SPAT) spatial_phase(act, vss + (size_t)j * MT, (const bf16*)(ws + WS_AWS) + (size_t)j * 16 * 128 * 128, a.in[10] + (size_t)j * D, a.in[12] + (size_t)j * 16 * 128, xn, M / 128, lds, vcu, G, tid, lane, wave); PH_END(); } ++pc;
            } else if (kind == 1) {
                if (PH_IN) { pg8::Gemm g{xn, (const bf16*)(ws + WS_BQKV), M, 6144, 2048}; pg8::StaticOrder S; S.init(M, 6144, G, bx);
                    pg8::EpiBf<2> E{act, 6144, qkss}; pg8::gemm_phase<pg8::EpiBf<2>, pg8::StaticOrder, true, true>(lds, g, S, E); PH_END(); } ++pc;
                if (PH_IN) { if (!NO_ATTN) attn_phase(act, qkss, a.in[15], a.in[16], a.in[17], xn, gw, NGW, lane); PH_END(); } ++pc;
            } else {
                if (PH_IN) { pg8::Gemm g{xn, (const bf16*)(ws + WS_CWIN), M, 2048, 2048}; pg8::StaticOrder S; S.init(M, 2048, G, bx);
                    pg8::EpiBf<0> E{act, 2048, nullptr}; pg8::gemm_phase<pg8::EpiBf<0>, pg8::StaticOrder, true, true>(lds, g, S, E); PH_END(); } ++pc;
                if (PH_IN) { if (!NO_SCAN) scan_phase(act, a.in[20], a.in[21], a.in[22], a.in[23], a.in[24], a.in[25], a.in[26], ybuf, lds, bx, G, wave, lane); PH_END(); } ++pc;
                if (PH_IN) { s5post_phase(act, ybuf, a.in[27], xn, M, gw, NGW, lane); PH_END(); } ++pc;
            }
            if (kind != 2) {
                if (PH_IN) { const bf16* wo = kind == 0 ? (const bf16*)(ws + WS_AWOUT) + (size_t)j * 2048 * 2048 : (const bf16*)(ws + WS_BWO);
                    pg8::Gemm g{xn, wo, M, 2048, 2048}; pg8::StaticOrder S; S.init(M, 2048, G, bx);
                    pg8::EpiRes E{a.out, hc, a.out, hc, modl + 5 * D, 1.0f}; pg8::gemm_phase<pg8::EpiRes, pg8::StaticOrder, true, true>(lds, g, S, E); PH_END(); } ++pc;
            } else {
                if (PH_IN) { pg8::Gemm g{xn, (const bf16*)(ws + WS_CGLU), M, 4096, 2048}; pg8::StaticOrder S; S.init(M, 4096, G, bx);
                    pg8::EpiGluRes E{a.out, hc, a.out, hc, modl + 5 * D}; pg8::gemm_phase<pg8::EpiGluRes, pg8::StaticOrder, true, true>(lds, g, S, E); PH_END(); } ++pc;
            }
        }
    }
#undef PH_IN
#undef PH_END
}

extern "C" void kernel_launch(void* const* d_in, const int* in_sizes, int n_in, void* d_out, int out_size, void* d_ws, size_t ws_size, hipStream_t stream) {
    static int grid = 0;
    if (grid == 0) {
        if (n_in != 29 || out_size != ML * D || ws_size < WS_END) { fprintf(stderr, "kernel_launch: unexpected shapes (n_in %d out %d ws %zu)\n", n_in, out_size, ws_size); grid = -1; return; }
        int dev = 0, cus = 0, per_cu = 0;
        if (hipGetDevice(&dev) != hipSuccess || hipDeviceGetAttribute(&cus, hipDeviceAttributeMultiprocessorCount, dev) != hipSuccess) { grid = -1; return; }
        if (hipFuncSetAttribute((const void*)fwd_kernel, hipFuncAttributeMaxDynamicSharedMemorySize, LDS_BYTES) != hipSuccess) { fprintf(stderr, "kernel_launch: hipFuncSetAttribute failed\n"); grid = -1; return; }
        if (hipOccupancyMaxActiveBlocksPerMultiprocessor(&per_cu, (const void*)fwd_kernel, NTHR, LDS_BYTES) != hipSuccess || per_cu < 1) fprintf(stderr, "kernel_launch: occupancy query says %d blocks per CU\n", per_cu);
        (void)hipGetLastError();
        grid = cus;
    }
    if (grid < 0) return;
    if (hipMemsetAsync(d_ws, 0, ZERO_BYTES, stream) != hipSuccess) { fprintf(stderr, "kernel_launch: memset failed\n"); return; }
    Args a{};
    for (int i = 0; i < 29; ++i) a.in[i] = (const float*)d_in[i];
    a.out = (float*)d_out; a.ws = (unsigned char*)d_ws; a.pad = 0;
#if MK_ONE_LAUNCH
    a.ph_lo = 0; a.ph_hi = NPHASES; a.li = 0;
    hipLaunchKernelGGL(fwd_kernel, dim3(grid), dim3(NTHR), LDS_BYTES, stream, a);
#else
    for (int k = 0; k < NPHASES; ++k) { a.ph_lo = k; a.ph_hi = k + 1; a.li = k;
        hipLaunchKernelGGL(fwd_kernel, dim3(grid), dim3(NTHR), LDS_BYTES, stream, a); }
#endif
    const hipError_t le = hipPeekAtLastError();
    if (le != hipSuccess) fprintf(stderr, "kernel_launch: launch failed: %s\n", hipGetErrorName(le));
}
```

```cpp
#include <hip/hip_runtime.h>
#include <cstdio>
#include <cstdint>
namespace pg8 {
#define PG8_LAS __attribute__((address_space(3)))
typedef unsigned short bf16_t;
typedef short bf16x8 __attribute__((ext_vector_type(8)));
typedef float f32x4 __attribute__((ext_vector_type(4)));
typedef unsigned u32x4 __attribute__((ext_vector_type(4)));
constexpr int BM = 256, BK = 64, HALF = 128, HTB = HALF * BK * 2  , STAGE_BYTES = 8 * HTB, NXCD = 8, WGM = 8;

__host__ __device__ __forceinline__ int lds_byte(int r, int c) { const int st = (r >> 4) * 2 + (c >> 5), rr = r & 15, cc = c & 31, ob = rr * 64 + cc * 2; return st * 1024 + (ob ^ (((ob >> 9) & 1) << 5)); }
__host__ __device__ __forceinline__ void stage_rc(int b, int& R, int& C) { const int st = b / 1024, sb = b % 1024, swz = sb ^ (((sb >> 9) & 1) << 5); R = (st >> 1) * 16 + swz / 64; C = (st & 1) * 32 + (swz % 64) / 2; }
__host__ __device__ __forceinline__ int perm32(int rho) { const int n = rho >> 4, i = rho & 15; return 8 * (i >> 2) + 4 * n + (i & 3); }

struct Unit { int pm, pn; };
struct Gemm { const bf16_t* A; const bf16_t* Bt; int M, N, K; };

struct StaticOrder {
    int nM, nN, nwg, G, c;
    __host__ __device__ void init(int M, int N, int G_, int c_) { nM = M / BM; nN = N / BM; nwg = nM * nN; G = G_; c = c_; }
    __host__ __device__ bool next(int i, Unit& u) const {
        const long L = (long)i * G + c; if (L >= nwg) return false;
        int wgid = (int)L; { const int q = nwg / NXCD, r = nwg % NXCD, xcd = wgid % NXCD, off = wgid / NXCD; wgid = (xcd < r ? xcd * (q + 1) : r * (q + 1) + (xcd - r) * q) + off; }
        const int nig = WGM * nN, gid = wgid / nig, fm = gid * WGM, gsz = (nM - fm) < WGM ? (nM - fm) : WGM;
        u.pm = fm + ((wgid % nig) % gsz); u.pn = (wgid % nig) / gsz; return true;
    }
    __device__ __forceinline__ void a_ready(const Unit&) const {}
    __device__ __forceinline__ void done(const Unit&) const {}
};
__device__ __forceinline__ unsigned cvt_pk_bf16(float lo, float hi) { unsigned r; asm volatile("v_cvt_pk_bf16_f32 %0, %1, %2" : "=v"(r) : "v"(lo), "v"(hi)); return r; }
__device__ __forceinline__ float fsigmoid(float x) { return __builtin_amdgcn_rcpf(1.0f + __builtin_amdgcn_exp2f(-1.44269504f * x)); }
__device__ __forceinline__ float fsilu(float x) { return x * fsigmoid(x); }
__device__ __forceinline__ float fgelu(float x) { return x * fsigmoid(1.5957691216f * (x + 0.044715f * x * x * x)); }
constexpr int ROWS_LAT = 8192, ROWS_ALL = 8704, MODW = 9 * 2048;

struct EpiSwiglu {
    static constexpr bool PERM = true, AFTER_DRAIN = false;
    bf16_t* O; int ldc;
    __device__ __forceinline__ void operator()(const f32x4 (&acc)[2][2][4][2], const Unit& u, int wr, int wc, int fr, int fq) const {
        const int row0 = u.pm * BM + wr * 64 + fr, col0 = u.pn * HALF + wc * 32 + 8 * fq;
#pragma unroll
        for (int ai = 0; ai < 2; ++ai)
#pragma unroll
            for (int m = 0; m < 4; ++m) { bf16_t* rowp = O + (size_t)(row0 + ai * HALF + m * 16) * ldc + col0;
                const f32x4 g0 = acc[ai][0][m][0], g1 = acc[ai][0][m][1], u0 = acc[ai][1][m][0], u1 = acc[ai][1][m][1];
                u32x4 w; w.x = cvt_pk_bf16(fsilu(g0[0]) * u0[0], fsilu(g0[1]) * u0[1]); w.y = cvt_pk_bf16(fsilu(g0[2]) * u0[2], fsilu(g0[3]) * u0[3]);
                w.z = cvt_pk_bf16(fsilu(g1[0]) * u1[0], fsilu(g1[1]) * u1[1]); w.w = cvt_pk_bf16(fsilu(g1[2]) * u1[2], fsilu(g1[3]) * u1[3]);
                *(u32x4*)rowp = w; }
    }
};
struct EpiRes {
    static constexpr bool PERM = false, AFTER_DRAIN = false;
    const float* blat; const float* bctx; float* olat; float* octx; const float* gate; float f;
    __device__ __forceinline__ void operator()(const f32x4 (&acc)[2][2][4][2], const Unit& u, int wr, int wc, int fr, int fq) const {
        const bool isctx = u.pm >= 32; const int cls = isctx ? 2 : (u.pm >> 4);
        const float* base = isctx ? bctx : blat; float* out = isctx ? octx : olat;
        const int row0 = (isctx ? u.pm - 32 : u.pm) * BM + wr * 64 + fr, col0 = u.pn * BM + wc * 32 + 4 * fq;
        const float* gp = gate + cls * MODW + col0;
        f32x4 gv[2][2];
#pragma unroll
        for (int bj = 0; bj < 2; ++bj)
#pragma unroll
            for (int n = 0; n < 2; ++n) gv[bj][n] = *(const f32x4*)(gp + bj * HALF + n * 16) * f;
#pragma unroll
        for (int ai = 0; ai < 2; ++ai)
#pragma unroll
            for (int m = 0; m < 4; ++m) { const size_t off = (size_t)(row0 + ai * HALF + m * 16) * 2048 + col0;
#pragma unroll
                for (int bj = 0; bj < 2; ++bj)
#pragma unroll
                    for (int n = 0; n < 2; ++n) { const f32x4 b = *(const f32x4*)(base + off + bj * HALF + n * 16); *(f32x4*)(out + off + bj * HALF + n * 16) = b + gv[bj][n] * acc[ai][bj][m][n]; } }
    }
};
struct EpiGluRes {
    static constexpr bool PERM = false, AFTER_DRAIN = false;
    const float* blat; const float* bctx; float* olat; float* octx; const float* gate;
    __device__ __forceinline__ void operator()(const f32x4 (&acc)[2][2][4][2], const Unit& u, int wr, int wc, int fr, int fq) const {
        const bool isctx = u.pm >= 32; const int cls = isctx ? 2 : (u.pm >> 4);
        const float* base = isctx ? bctx : blat; float* out = isctx ? octx : olat;
        const int row0 = (isctx ? u.pm - 32 : u.pm) * BM + wr * 64 + fr, col0 = u.pn * HALF + wc * 32 + 4 * fq;
        const float* gp = gate + cls * MODW + col0;
        f32x4 gv[2];
#pragma unroll
        for (int n = 0; n < 2; ++n) gv[n] = *(const f32x4*)(gp + n * 16);
#pragma unroll
        for (int ai = 0; ai < 2; ++ai)
#pragma unroll
            for (int m = 0; m < 4; ++m) { const size_t off = (size_t)(row0 + ai * HALF + m * 16) * 2048 + col0;
#pragma unroll
                for (int n = 0; n < 2; ++n) { const f32x4 b = *(const f32x4*)(base + off + n * 16); const f32x4 av = acc[ai][0][m][n], gg = acc[ai][1][m][n];
                    f32x4 v; v[0] = av[0] * fsigmoid(gg[0]); v[1] = av[1] * fsigmoid(gg[1]); v[2] = av[2] * fsigmoid(gg[2]); v[3] = av[3] * fsigmoid(gg[3]);
                    *(f32x4*)(out + off + n * 16) = b + gv[n] * v; } }
    }
};
template <int MODE> struct EpiBf {
    static constexpr bool PERM = true, AFTER_DRAIN = false;
    bf16_t* O; int ldc; float* ss;
    __device__ __forceinline__ void operator()(const f32x4 (&acc)[2][2][4][2], const Unit& u, int wr, int wc, int fr, int fq) const {
        const int row0 = u.pm * BM + wr * 64 + fr, col0 = u.pn * BM + wc * 32 + 8 * fq;
#pragma unroll
        for (int ai = 0; ai < 2; ++ai)
#pragma unroll
            for (int m = 0; m < 4; ++m) { const int row = row0 + ai * HALF + m * 16; bf16_t* rowp = O + (size_t)row * ldc + col0; float s1 = 0.f;
#pragma unroll
                for (int bj = 0; bj < 2; ++bj) { f32x4 v0 = acc[ai][bj][m][0], v1 = acc[ai][bj][m][1];
                    if (MODE == 1) {
#pragma unroll
                        for (int j = 0; j < 4; ++j) { v0[j] = fgelu(v0[j]); v1[j] = fgelu(v1[j]); } }
                    u32x4 w; w.x = cvt_pk_bf16(v0[0], v0[1]); w.y = cvt_pk_bf16(v0[2], v0[3]); w.z = cvt_pk_bf16(v1[0], v1[1]); w.w = cvt_pk_bf16(v1[2], v1[3]);
                    *(u32x4*)(rowp + bj * HALF) = w;
                    if (MODE != 0) { float s = (v0[0] * v0[0] + v0[1] * v0[1]) + (v0[2] * v0[2] + v0[3] * v0[3]) + (v1[0] * v1[0] + v1[1] * v1[1]) + (v1[2] * v1[2] + v1[3] * v1[3]);
                        if (MODE == 2) { if (u.pn < 16) { s += __shfl_xor(s, 16); s += __shfl_xor(s, 32); if (fq == 0) unsafeAtomicAdd(ss + (size_t)(2 * u.pn + bj) * ROWS_ALL + row, s); } }
                        else s1 += s; } }
                if (MODE == 1) { if (u.pn >= 8) { s1 += __shfl_xor(s1, 16); s1 += __shfl_xor(s1, 32); if (fq == 0) unsafeAtomicAdd(ss + row, s1); } } }
    }
};

template <class Epi, class Sched, bool ALIGN_EPI = false, bool SP2 = false>
__device__ __forceinline__ void gemm_phase(PG8_LAS unsigned char* lds, const Gemm g, const Sched& S, const Epi& E) {
    int tid_l = threadIdx.x; asm volatile("" : "+v"(tid_l));
    const int tid = tid_l, wid = __builtin_amdgcn_readfirstlane(tid >> 6), lane = tid & 63, wr = wid >> 2, wc = wid & 3, fr = lane & 15, fq = lane >> 4;
    const int K = g.K, nt = K / BK;
    unsigned voffA[2], voffB[2];
#pragma unroll
    for (int i = 0; i < 2; ++i) { int R, C; stage_rc(tid * 16 + i * 8192, R, C); const int Rb = Epi::PERM ? ((R & ~31) + perm32(R & 31)) : R;
        voffA[i] = (unsigned)(R * K + C) * 2u; voffB[i] = (unsigned)(Rb * K + C) * 2u; }
    const size_t kstep = (size_t)(BK * 2);
    const size_t hstep = (size_t)HALF * K * 2;
    const size_t tstep = 2 * hstep;
    const unsigned ldsw = (unsigned)wid * 1024u;
    const int aoff = lds_byte(wr * 64 + fr, fq * 8), boff = lds_byte(wc * 32 + fr, fq * 8);
#define PG8_SA(b, h) (((b) * 2 + (h)) * HTB)
#define PG8_SB(b, h) ((4 + (b) * 2 + (h)) * HTB)
#define PG8_STAGE(bufoff, gbase, voff) do { _Pragma("unroll") for (int _i = 0; _i < 2; ++_i) \
        __builtin_amdgcn_global_load_lds((const unsigned*)((const char*)(gbase) + (voff)[_i]), (PG8_LAS unsigned*)(lds + (bufoff) + ldsw + _i * 8192), 16, 0, 0); } while (0)
#define PG8_LDA(dst, b, h) do { _Pragma("unroll") for (int m = 0; m < 4; ++m) _Pragma("unroll") for (int k = 0; k < 2; ++k) dst[m][k] = *(const PG8_LAS bf16x8*)(lds + PG8_SA(b, h) + aoff + m * 2048 + k * 1024); } while (0)
#define PG8_LDB(dst, b, h) do { _Pragma("unroll") for (int n = 0; n < 2; ++n) _Pragma("unroll") for (int k = 0; k < 2; ++k) dst[n][k] = *(const PG8_LAS bf16x8*)(lds + PG8_SB(b, h) + boff + n * 2048 + k * 1024); } while (0)
#define PG8_MMA(ai, bj, At, Bt) do { __builtin_amdgcn_s_setprio(1); _Pragma("unroll") for (int m = 0; m < 4; ++m) _Pragma("unroll") for (int n = 0; n < 2; ++n) _Pragma("unroll") for (int k = 0; k < 2; ++k) \
        acc[ai][bj][m][n] = __builtin_amdgcn_mfma_f32_16x16x32_bf16(Bt[n][k], At[m][k], acc[ai][bj][m][n], 0, 0, 0); __builtin_amdgcn_s_setprio(0); } while (0)
#define PG8_WAIT_V(n) asm volatile("s_waitcnt vmcnt(" #n ")" ::: "memory")
#define PG8_WAIT_L(n) asm volatile("s_waitcnt lgkmcnt(" #n ")" ::: "memory")
#define PG8_BAR __builtin_amdgcn_s_barrier()
#define PG8_SCHED __builtin_amdgcn_sched_barrier(0)
    Unit cur, nxt; int ui = 0;
    if (!S.next(0, cur)) return;
    f32x4 acc[2][2][4][2];
#pragma unroll
    for (int a = 0; a < 2; ++a)
#pragma unroll
        for (int b = 0; b < 2; ++b)
#pragma unroll
            for (int m = 0; m < 4; ++m)
#pragma unroll
                for (int n = 0; n < 2; ++n) acc[a][b][m][n] = (f32x4){0.f, 0.f, 0.f, 0.f};
    bf16x8 At[4][2], B0[2][2], B1[2][2];
    const char* cA = (const char*)g.A + (size_t)cur.pm * tstep; const char* cB = (const char*)g.Bt + (size_t)cur.pn * tstep;
    S.a_ready(cur);
    if constexpr (SP2) {
        PG8_STAGE(PG8_SB(0, 0), cB, voffB); PG8_STAGE(PG8_SB(0, 1), cB + hstep, voffB); PG8_STAGE(PG8_SA(0, 0), cA, voffA); PG8_STAGE(PG8_SA(0, 1), cA + hstep, voffA);
        if (wr == 1) PG8_BAR;
        PG8_WAIT_V(2); PG8_BAR;
        PG8_STAGE(PG8_SB(1, 0), cB + kstep, voffB); PG8_STAGE(PG8_SA(1, 0), cA + kstep, voffA); PG8_STAGE(PG8_SB(1, 1), cB + hstep + kstep, voffB);
        PG8_WAIT_V(6); PG8_BAR;
    } else {
        PG8_STAGE(PG8_SB(0, 0), cB, voffB); PG8_STAGE(PG8_SA(0, 0), cA, voffA); PG8_STAGE(PG8_SB(0, 1), cB + hstep, voffB); PG8_STAGE(PG8_SA(0, 1), cA + hstep, voffA);
        if (wr == 1) PG8_BAR;
        PG8_WAIT_V(4); PG8_BAR;
        PG8_STAGE(PG8_SB(1, 0), cB + kstep, voffB); PG8_STAGE(PG8_SA(1, 0), cA + kstep, voffA); PG8_STAGE(PG8_SB(1, 1), cB + hstep + kstep, voffB);
        PG8_WAIT_V(6); PG8_BAR;
    }
    for (;;) {
        const bool has_next = S.next(ui + 1, nxt);
        const char* nA = has_next ? (const char*)g.A + (size_t)nxt.pm * tstep : cA; const char* nB = has_next ? (const char*)g.Bt + (size_t)nxt.pn * tstep : cB;
        for (int t = 0; t < nt; t += 2) {
            const bool last = (t == nt - 2);
            const char* a1 = cA + (size_t)(t + 1) * kstep;
            const char* a2 = last ? nA : cA + (size_t)(t + 2) * kstep; const char* b2 = last ? nB : cB + (size_t)(t + 2) * kstep;
            const char* a3 = a2 + kstep; const char* b3 = b2 + kstep;
            if (last && has_next) S.a_ready(nxt);
            if constexpr (SP2) {
            PG8_LDB(B0, 0, 0); PG8_LDB(B1, 0, 1); PG8_SCHED; PG8_LDA(At, 0, 0); PG8_STAGE(PG8_SA(1, 1), a1 + hstep, voffA);
            PG8_WAIT_V(8); PG8_WAIT_L(0); PG8_BAR; PG8_MMA(0, 0, At, B0); PG8_MMA(0, 1, At, B1); PG8_BAR; PG8_SCHED;
            PG8_LDA(At, 0, 1); PG8_STAGE(PG8_SB(0, 0), b2, voffB); PG8_STAGE(PG8_SB(0, 1), b2 + hstep, voffB); PG8_STAGE(PG8_SA(0, 0), a2, voffA);
            PG8_WAIT_V(8); PG8_WAIT_L(0); PG8_BAR; PG8_MMA(1, 0, At, B0); PG8_MMA(1, 1, At, B1); PG8_BAR; PG8_SCHED;
            PG8_LDB(B0, 1, 0); PG8_LDB(B1, 1, 1); PG8_SCHED; PG8_LDA(At, 1, 0); PG8_STAGE(PG8_SA(0, 1), a2 + hstep, voffA);
            PG8_WAIT_V(8); PG8_WAIT_L(0); PG8_BAR; PG8_MMA(0, 0, At, B0); PG8_MMA(0, 1, At, B1); PG8_BAR; PG8_SCHED;
            PG8_LDA(At, 1, 1); PG8_STAGE(PG8_SB(1, 0), b3, voffB); PG8_STAGE(PG8_SB(1, 1), b3 + hstep, voffB); PG8_STAGE(PG8_SA(1, 0), a3, voffA);
            PG8_WAIT_V(8); PG8_WAIT_L(0); PG8_BAR; PG8_MMA(1, 0, At, B0); PG8_MMA(1, 1, At, B1); PG8_BAR; PG8_SCHED;
            } else {
            PG8_LDB(B0, 0, 0); PG8_SCHED; PG8_LDA(At, 0, 0); PG8_STAGE(PG8_SA(1, 1), a1 + hstep, voffA);
            PG8_WAIT_L(8); PG8_BAR; PG8_WAIT_L(0); PG8_MMA(0, 0, At, B0); PG8_BAR; PG8_SCHED;
            PG8_LDB(B1, 0, 1); PG8_STAGE(PG8_SB(0, 0), b2, voffB);
            PG8_BAR; PG8_WAIT_L(0); PG8_MMA(0, 1, At, B1); PG8_BAR;
            PG8_LDA(At, 0, 1); PG8_STAGE(PG8_SA(0, 0), a2, voffA);
            PG8_BAR; PG8_WAIT_L(0); PG8_MMA(1, 0, At, B0); PG8_BAR; PG8_SCHED;
            PG8_STAGE(PG8_SB(0, 1), b2 + hstep, voffB);
            PG8_WAIT_V(6); PG8_BAR; PG8_MMA(1, 1, At, B1); PG8_BAR;
            PG8_LDB(B0, 1, 0); PG8_SCHED; PG8_LDA(At, 1, 0); PG8_STAGE(PG8_SA(0, 1), a2 + hstep, voffA);
            PG8_WAIT_L(8); PG8_BAR; PG8_WAIT_L(0); PG8_MMA(0, 0, At, B0); PG8_BAR; PG8_SCHED;
            PG8_LDB(B1, 1, 1); PG8_STAGE(PG8_SB(1, 0), b3, voffB);
            PG8_BAR; PG8_WAIT_L(0); PG8_MMA(0, 1, At, B1); PG8_BAR;
            PG8_LDA(At, 1, 1); PG8_STAGE(PG8_SA(1, 0), a3, voffA);
            PG8_BAR; PG8_WAIT_L(0); PG8_MMA(1, 0, At, B0); PG8_BAR; PG8_SCHED;
            PG8_STAGE(PG8_SB(1, 1), b3 + hstep, voffB);
            PG8_WAIT_V(6); PG8_BAR; PG8_MMA(1, 1, At, B1); PG8_BAR;
            }
        }
        if constexpr (ALIGN_EPI) { if (wr == 0) PG8_BAR; }
        if constexpr (!Epi::AFTER_DRAIN) { E(acc, cur, wr, wc, fr, fq); S.done(cur); }
        if (!has_next) break;
#pragma unroll
        for (int a = 0; a < 2; ++a)
#pragma unroll
            for (int b = 0; b < 2; ++b)
#pragma unroll
                for (int m = 0; m < 4; ++m)
#pragma unroll
                    for (int n = 0; n < 2; ++n) acc[a][b][m][n] = (f32x4){0.f, 0.f, 0.f, 0.f};
        cur = nxt; cA = nA; cB = nB; ++ui;
        if constexpr (ALIGN_EPI) { if (wr == 1) PG8_BAR; }
    }
    PG8_WAIT_V(0);
    if constexpr (!ALIGN_EPI) { if (wr == 0) PG8_BAR; }
    PG8_BAR;
    if constexpr (Epi::AFTER_DRAIN) { E.fused(acc, cur, wr, wc, fr, fq, lds, wid, lane); S.done(cur); }
#undef PG8_SA
#undef PG8_SB
#undef PG8_STAGE
#undef PG8_LDA
#undef PG8_LDB
#undef PG8_MMA
#undef PG8_WAIT_V
#undef PG8_WAIT_L
#undef PG8_BAR
#undef PG8_SCHED
}
}
#define XB_TMO      128
#define XB_XCNT(j)  (256  + 64 * (j))
#define XB_XSUB(j)  (1280 + 64 * (j))
#define XB_XGEN(j)  (2304 + 64 * (j))
#define XB_TOP      3328
#define XB_TOPGEN   3392
#define XCD_BAR_WORDS 3456
#define XB_SPIN_CAP (1u << 18)
#define LAS __attribute__((address_space(3)))

__device__ __forceinline__ unsigned xb_ld(unsigned* p)              { return __hip_atomic_load(p, __ATOMIC_RELAXED, __HIP_MEMORY_SCOPE_AGENT); }
__device__ __forceinline__ unsigned xb_add(unsigned* p, unsigned v) { return __hip_atomic_fetch_add(p, v, __ATOMIC_RELAXED, __HIP_MEMORY_SCOPE_AGENT); }
__device__ __forceinline__ unsigned xb_xcc_id() { return (unsigned)__builtin_amdgcn_s_getreg((3 << 11) | 20) & 0xFu; }
#define XB_SPIN(cond, bar) do { unsigned _sp = 0; while (cond) { __builtin_amdgcn_s_sleep(1); \
    if ((++_sp & 255u) == 0u) { if (xb_ld(&(bar)[XB_TMO])) break; if (_sp > XB_SPIN_CAP) { atomicAdd(&(bar)[XB_TMO], 1u); break; } } } } while (0)

struct XcdBarrier {
    unsigned* bar; unsigned x;
    volatile LAS unsigned* st;
};

__device__ __forceinline__ XcdBarrier xcd_barrier_post(unsigned* bar, volatile LAS unsigned* st) {
    XcdBarrier b; b.bar = bar; b.x = xb_xcc_id(); b.st = st;
    if (threadIdx.x == 0) (void)xb_add(&bar[XB_XCNT(b.x)], 1u);
    return b;
}
__device__ __forceinline__ void xcd_barrier_complete(unsigned* bar, unsigned x, unsigned& nloc, unsigned& nx) {
    const unsigned G = gridDim.x * gridDim.y * gridDim.z;
    unsigned sum, cnt, mine, sp = 0u;
    for (;;) {
        sum = 0u; cnt = 0u; mine = 0u;
#pragma unroll
        for (unsigned j = 0; j < 16; ++j) { const unsigned c = xb_ld(&bar[XB_XCNT(j)]); sum += c; cnt += (c > 0u) ? 1u : 0u; mine = (j == x) ? c : mine; }
        if (sum == G) break;
        __builtin_amdgcn_s_sleep(1);
        if ((++sp & 255u) == 0u) { if (xb_ld(&bar[XB_TMO])) break; if (sp > XB_SPIN_CAP) { atomicAdd(&bar[XB_TMO], 1u); break; } }
    }
    nloc = mine > 0u ? mine : 1u; nx = cnt > 0u ? cnt : 1u;
}

__device__ __forceinline__ void xcd_barrier(const XcdBarrier& b) {
    asm volatile("s_waitcnt vmcnt(0)" ::: "memory");
    __syncthreads();
    if (threadIdx.x == 0) {
        unsigned* bar = b.bar;
        __builtin_amdgcn_s_waitcnt(0);
        unsigned nloc = b.st[0], nx = b.st[1];
        if (nloc == 0u) { xcd_barrier_complete(bar, b.x, nloc, nx); b.st[0] = nloc; b.st[1] = nx; }
        const unsigned old = xb_add(&bar[XB_XSUB(b.x)], 1u);
        const unsigned gen = old / nloc;
        if (old + 1u == (gen + 1u) * nloc) {
            __builtin_amdgcn_fence(__ATOMIC_RELEASE, "agent");
            asm volatile("s_waitcnt vmcnt(0)" ::: "memory");
            const unsigned og = xb_add(&bar[XB_TOP], 1u);
            const unsigned tg = og / nx;
            if (og + 1u == (tg + 1u) * nx) xb_add(&bar[XB_TOPGEN], 1u);
            else XB_SPIN(xb_ld(&bar[XB_TOPGEN]) == tg, bar);
            __builtin_amdgcn_fence(__ATOMIC_ACQUIRE, "agent");
            xb_add(&bar[XB_XGEN(b.x)], 1u);
            asm volatile("s_waitcnt vmcnt(0)" ::: "memory");
        } else {
            XB_SPIN(xb_ld(&bar[XB_XGEN(b.x)]) == gen, bar);
            __builtin_amdgcn_fence(__ATOMIC_ACQUIRE, "agent");
            asm volatile("s_waitcnt vmcnt(0)" ::: "memory");
        }
    }
    __syncthreads();
}
#define GAS __attribute__((address_space(1)))
typedef unsigned short bf16;
typedef float v4f __attribute__((ext_vector_type(4)));
typedef float v2f __attribute__((ext_vector_type(2)));
typedef float v16f __attribute__((ext_vector_type(16)));
typedef short b8 __attribute__((ext_vector_type(8)));
typedef unsigned v4u __attribute__((ext_vector_type(4)));
typedef unsigned v2u __attribute__((ext_vector_type(2)));
#define LDS_WAIT() asm volatile("s_waitcnt lgkmcnt(0)" ::: "memory")
#define MFMA32(a, b, c) __builtin_amdgcn_mfma_f32_32x32x16_bf16((a), (b), (c), 0, 0, 0)
#define MFMA16(a, b, c) __builtin_amdgcn_mfma_f32_16x16x32_bf16((a), (b), (c), 0, 0, 0)

using pg8::MODW;
constexpr int NWAVES = 8, NTHR = 512;
constexpr int D = 2048, DFF = 5632, ML = 8192, MC = 512, MT = 8704;
constexpr float RMS_EPS = 1e-6f;
#ifndef MK_ONE_LAUNCH
#define MK_ONE_LAUNCH 1
#endif
constexpr int NPHASES = 42;
#ifndef NO_ATTN
#define NO_ATTN 0
#endif
#ifndef NO_SCAN
#define NO_SCAN 0
#endif
#ifndef NO_SPAT
#define NO_SPAT 0
#endif
#ifndef NO_P0
#define NO_P0 0
#endif

constexpr size_t MiB = 1u << 20;
constexpr size_t WS_CTL = 0;
constexpr size_t WS_VSS = 1 * MiB;
constexpr size_t WS_QKSS = 1 * MiB + 128 * 1024;
constexpr size_t WS_MOD = 3 * MiB;
constexpr size_t ZERO_BYTES = 4 * MiB;
constexpr size_t WS_HC = 4 * MiB;
constexpr size_t WS_XN = 8 * MiB;
constexpr size_t WS_ACT = 42 * MiB;
constexpr size_t WS_Y = 144 * MiB;
constexpr size_t WS_WGU = 280 * MiB, WS_WDN = 632 * MiB, WS_AWIN = 808 * MiB, WS_AWOUT = 840 * MiB, WS_AWS = 856 * MiB;
constexpr size_t WS_BQKV = 857 * MiB, WS_BWO = 881 * MiB, WS_CWIN = 889 * MiB, WS_CGLU = 897 * MiB, WS_END = 913 * MiB;
constexpr int CW_BAR = 4096, BAR_STRIDE = 3584;
static_assert((CW_BAR + 48 * BAR_STRIDE) * 4 <= (int)MiB, "ctl");
constexpr int LDS_BYTES = 147456;
constexpr int MISC_OFF = 131072 + 320;

__device__ __forceinline__ float bf2f(unsigned short b) { return __uint_as_float(((unsigned)b) << 16); }
__device__ __forceinline__ unsigned pk_bf16(float lo, float hi) { return pg8::cvt_pk_bf16(lo, hi); }
__device__ __forceinline__ unsigned pk_bf16_m(float lo, float hi) { unsigned r; asm volatile("v_cvt_pk_bf16_f32 %0, %1, %2\n\ts_nop 1" : "=v"(r) : "v"(lo), "v"(hi)); return r; }
__device__ __forceinline__ float wave_sum(float v) {
#pragma unroll
    for (int o = 1; o < 64; o <<= 1) v += __shfl_xor(v, o);
    return v;
}

#define OPAQUE_V(x) asm volatile("" : "+v"(x))
struct Args { const float* in[29]; float* out; unsigned char* ws; int ph_lo, ph_hi, li, pad; };

__device__ __forceinline__ void tr_item(const float* W, int K, int N, bf16* WT, int nh, int item, LAS float* scr, int lane) {
    const int nblk = N / 32, kb = item / nblk, nb = item - kb * nblk, k0 = 64 * kb, n0 = 32 * nb;
    int drow0 = n0; if (nh) { const int half = n0 >= nh ? 1 : 0, c = n0 - half * nh; drow0 = 256 * (c >> 7) + 128 * half + (c & 127); }
    const float* src = W + (size_t)k0 * N + n0 + (lane & 31) + (size_t)(lane >> 5) * N;
#pragma unroll 8
    for (int i = 0; i < 32; ++i) scr[(2 * i + (lane >> 5)) * 33 + (lane & 31)] = src[(size_t)(2 * i) * N];
    LDS_WAIT(); asm volatile("" ::: "memory");
    const int c = lane & 7;
#pragma unroll
    for (int j = 0; j < 4; ++j) { const int n = (lane >> 3) + 8 * j; const LAS float* s = scr + (8 * c) * 33 + n;
        v4u o; o.x = pk_bf16(s[0 * 33], s[1 * 33]); o.y = pk_bf16(s[2 * 33], s[3 * 33]); o.z = pk_bf16(s[4 * 33], s[5 * 33]); o.w = pk_bf16(s[6 * 33], s[7 * 33]);
        *(v4u*)(WT + (size_t)(drow0 + n) * K + k0 + 8 * c) = o; }
    LDS_WAIT(); asm volatile("" ::: "memory");
}
__device__ __forceinline__ void p0_prologue(const Args& a, LAS unsigned char* lds, int gw, int NGW, int tid, int lane, int wave) {
    OPAQUE_V(tid); OPAQUE_V(lane);
    LAS float* sl = (LAS float*)(lds + 73728);
    for (int i = tid; i < 3 * 2048; i += NTHR) { const float v = i < 4096 ? a.in[1][i] : a.in[3][i - 4096]; sl[i] = v / (1.0f + __expf(-v)); }
    __syncthreads();
    LAS float* scr = (LAS float*)(lds + wave * 8704);
    unsigned char* ws = a.ws;
    constexpr int I_ADA = 4 * 72 * 16, I_GU = 32 * 352, I_DN = 88 * 64, I_AIN = 32 * 128, I_SQ = 32 * 64, I_QKV = 32 * 192, I_WS = 256;
    constexpr int NITEMS = I_ADA + 8 * I_GU + 8 * I_DN + 2 * I_AIN + 2 * I_SQ + I_QKV + I_SQ + I_SQ + I_AIN + I_WS;
    for (int it = gw; it < NITEMS; it += NGW) {
        int r = it;
        if (r < I_ADA) {
            const int layer = r / 1152, rr = r - layer * 1152, cb = rr >> 4, ks = rr & 15, n0 = cb * 256 + lane * 4, k0 = ks * 128;
            const float* Wp = a.in[4] + (size_t)layer * 2048 * MODW + (size_t)k0 * MODW + n0;
            v4f a0 = {0.f, 0.f, 0.f, 0.f}, a1 = a0, a2 = a0;
#pragma unroll 8
            for (int k = 0; k < 128; ++k) { const v4f w = *(const v4f*)(Wp + (size_t)k * MODW); a0 += w * sl[k0 + k]; a1 += w * sl[2048 + k0 + k]; a2 += w * sl[4096 + k0 + k]; }
            if (ks == 0) { const v4f bv = *(const v4f*)(a.in[5] + (size_t)layer * MODW + n0); a0 += bv; a1 += bv; a2 += bv; }
            float* mp = (float*)(ws + WS_MOD) + (size_t)layer * 3 * MODW + n0;
#pragma unroll
            for (int j = 0; j < 4; ++j) { unsafeAtomicAdd(mp + j, a0[j]); unsafeAtomicAdd(mp + MODW + j, a1[j]); unsafeAtomicAdd(mp + 2 * MODW + j, a2[j]); }
            continue; }
        r -= I_ADA;
        if (r < 8 * I_GU) { const int f = r / I_GU; tr_item(a.in[7] + (size_t)f * 2048 * 11264, 2048, 11264, (bf16*)(ws + WS_WGU) + (size_t)f * 11264 * 2048, 5632, r - f * I_GU, scr, lane); continue; } r -= 8 * I_GU;
        if (r < 8 * I_DN) { const int f = r / I_DN; tr_item(a.in[8] + (size_t)f * 5632 * 2048, 5632, 2048, (bf16*)(ws + WS_WDN) + (size_t)f * 2048 * 5632, 0, r - f * I_DN, scr, lane); continue; } r -= 8 * I_DN;
        if (r < 2 * I_AIN) { const int j = r / I_AIN; tr_item(a.in[9] + (size_t)j * 2048 * 4096, 2048, 4096, (bf16*)(ws + WS_AWIN) + (size_t)j * 4096 * 2048, 0, r - j * I_AIN, scr, lane); continue; } r -= 2 * I_AIN;
        if (r < 2 * I_SQ) { const int j = r / I_SQ; tr_item(a.in[13] + (size_t)j * 2048 * 2048, 2048, 2048, (bf16*)(ws + WS_AWOUT) + (size_t)j * 2048 * 2048, 0, r - j * I_SQ, scr, lane); continue; } r -= 2 * I_SQ;
        if (r < I_QKV) { tr_item(a.in[14], 2048, 6144, (bf16*)(ws + WS_BQKV), 0, r, scr, lane); continue; } r -= I_QKV;
        if (r < I_SQ) { tr_item(a.in[18], 2048, 2048, (bf16*)(ws + WS_BWO), 0, r, scr, lane); continue; } r -= I_SQ;
        if (r < I_SQ) { tr_item(a.in[19], 2048, 2048, (bf16*)(ws + WS_CWIN), 0, r, scr, lane); continue; } r -= I_SQ;
        if (r < I_AIN) { tr_item(a.in[28], 2048, 4096, (bf16*)(ws + WS_CGLU), 2048, r, scr, lane); continue; } r -= I_AIN;
        { const float* s = a.in[11] + (size_t)r * 2048 + lane * 4; bf16* d = (bf16*)(ws + WS_AWS) + (size_t)r * 2048 + lane * 4;
#pragma unroll
          for (int j = 0; j < 8; ++j) { const v4f v = *(const v4f*)(s + 256 * j); v2u o; o.x = pk_bf16(v[0], v[1]); o.y = pk_bf16(v[2], v[3]); *(v2u*)(d + 256 * j) = o; } }
    }
}

__device__ __forceinline__ void norm_phase(const float* hlat, const float* hctx, const float* gain, const float* modl, int s, bf16* xn, int M, int gw, int NGW, int lane) {
    OPAQUE_V(lane);
    for (int row = gw; row < M; row += NGW) {
        const bool isctx = row >= ML; const int cls = isctx ? 2 : (row >> 12);
        const v4f* xr = (const v4f*)(isctx ? hctx + (size_t)(row - ML) * D : hlat + (size_t)row * D) + lane;
        const v4f* sh = (const v4f*)(modl + cls * MODW + (3 * s) * D) + lane; const v4f* sc = sh + D / 4; const v4f* gn = (const v4f*)gain + lane;
        v4f v[8]; float ss = 0.f;
#pragma unroll
        for (int j = 0; j < 8; ++j) { v[j] = xr[64 * j]; ss += (v[j][0] * v[j][0] + v[j][1] * v[j][1]) + (v[j][2] * v[j][2] + v[j][3] * v[j][3]); }
        const float r = rsqrtf(wave_sum(ss) * (1.0f / D) + RMS_EPS);
        v2u* o = (v2u*)(xn + (size_t)row * D) + lane;
#pragma unroll
        for (int j = 0; j < 8; ++j) { const v4f y = v[j] * r * gn[64 * j] * (sc[64 * j] + 1.0f) + sh[64 * j]; v2u w; w.x = pk_bf16(y[0], y[1]); w.y = pk_bf16(y[2], y[3]); o[64 * j] = w; }
    }
}

__device__ __forceinline__ void spatial_phase(const bf16* uv, const float* vss, const bf16* wsb, const float* vgain, const float* bsg, bf16* su, int nchunk,
                                              LAS unsigned char* lds, int vcu, int G, int tid, int lane, int wave) {
    OPAQUE_V(tid); OPAQUE_V(lane);
    LAS float* rq = (LAS float*)lds;
    const int h = lane >> 5, r32 = lane & 31, cb = wave & 3, pb0 = (wave >> 2) * 2;
    for (int unit = vcu; unit < nchunk * 16; unit += G) {
        const int ch = unit >> 4, g = unit & 15, row0 = ch * 128;
        __syncthreads();
        if (tid < 128) rq[tid] = rsqrtf(vss[row0 + tid] * (1.0f / D) + RMS_EPS);
        __syncthreads();
        const bf16* vp = uv + (size_t)row0 * 4096 + 2048 + 128 * g + 32 * cb + r32;
        b8 Af[8];
#pragma unroll
        for (int s = 0; s < 8; ++s) { float x[8];
#pragma unroll
            for (int j = 0; j < 8; ++j) { const int q = 16 * s + 8 * h + j; x[j] = bf2f(vp[(size_t)q * 4096]) * rq[q]; }
            v4u w; w.x = pk_bf16_m(x[0], x[1]); w.y = pk_bf16_m(x[2], x[3]); w.z = pk_bf16_m(x[4], x[5]); w.w = pk_bf16_m(x[6], x[7]); Af[s] = __builtin_bit_cast(b8, w); }
        v16f acc[2];
#pragma unroll
        for (int pbi = 0; pbi < 2; ++pbi) {
#pragma unroll
            for (int i = 0; i < 16; ++i) acc[pbi][i] = 0.f;
            const bf16* wp = wsb + ((size_t)g * 128 + 32 * (pb0 + pbi) + r32) * 128 + 8 * h;
#pragma unroll
            for (int s = 0; s < 8; ++s) { const b8 Bf = *(const b8*)(wp + 16 * s); acc[pbi] = MFMA32(Af[s], Bf, acc[pbi]); } }
#pragma unroll
        for (int pbi = 0; pbi < 2; ++pbi) { const int p = 32 * (pb0 + pbi) + r32; const float bsp = bsg[g * 128 + p]; const size_t row = (size_t)(row0 + p);
#pragma unroll
            for (int i4 = 0; i4 < 4; ++i4) { const int cc = 128 * g + 32 * cb + 8 * i4 + 4 * h; const v4f vg = *(const v4f*)(vgain + cc);
                const v2u uu = *(const v2u*)(uv + row * 4096 + cc);
                const float u0 = __uint_as_float(uu.x << 16), u1 = __uint_as_float(uu.x & 0xffff0000u), u2 = __uint_as_float(uu.y << 16), u3 = __uint_as_float(uu.y & 0xffff0000u);
                v2u w; w.x = pk_bf16(u0 * (acc[pbi][4 * i4 + 0] * vg[0] + bsp), u1 * (acc[pbi][4 * i4 + 1] * vg[1] + bsp)); w.y = pk_bf16(u2 * (acc[pbi][4 * i4 + 2] * vg[2] + bsp), u3 * (acc[pbi][4 * i4 + 3] * vg[3] + bsp));
                *(v2u*)(su + row * D + cc) = w; } }
    }
}

__device__ __forceinline__ void attn_phase(const bf16* qkv, const float* qkss, const float* qgain, const float* kgain, const float* rpb, bf16* o, int gw, int NGW, int lane) {
    OPAQUE_V(lane);
    const int h = lane >> 5, r32 = lane & 31;
    constexpr int NU_LAT = 2 * 16 * 64 * 2, NU_CTX = 2 * 16 * 8;
    for (int wu = gw; wu < NU_LAT + NU_CTX; wu += NGW) {
        const bool lat = wu < NU_LAT;
        int b, hd, qrow, r = 0, qh = 0, rstart = 0;
        if (lat) { qh = wu & 1; r = (wu >> 1) & 63; hd = (wu >> 7) & 15; b = wu >> 11; qrow = b * 4096 + r * 64 + 32 * qh + r32; rstart = r - 4 < 0 ? 0 : (r - 4 > 56 ? 56 : r - 4); }
        else { const int w = wu - NU_LAT; hd = (w >> 3) & 15; b = w >> 7; qrow = ML + b * 256 + 32 * (w & 7) + r32; }
        const float rqv = rsqrtf(qkss[(size_t)hd * MT + qrow] * (1.0f / 128.0f) + RMS_EPS) * 0.08838834764831845f;
        const bf16* qp = qkv + (size_t)qrow * 6144 + 128 * hd + 8 * h;
        b8 Qf[8];
#pragma unroll
        for (int s = 0; s < 8; ++s) { const v4u raw = *(const v4u*)(qp + 16 * s); const int d0 = 16 * s + 8 * h;
            const v4f g0 = *(const v4f*)(qgain + d0), g1 = *(const v4f*)(qgain + d0 + 4), k0 = *(const v4f*)(kgain + d0), k1 = *(const v4f*)(kgain + d0 + 4);
            v4u w;
            w.x = pk_bf16_m(__uint_as_float(raw.x << 16) * rqv * g0[0] * k0[0], __uint_as_float(raw.x & 0xffff0000u) * rqv * g0[1] * k0[1]);
            w.y = pk_bf16_m(__uint_as_float(raw.y << 16) * rqv * g0[2] * k0[2], __uint_as_float(raw.y & 0xffff0000u) * rqv * g0[3] * k0[3]);
            w.z = pk_bf16_m(__uint_as_float(raw.z << 16) * rqv * g1[0] * k1[0], __uint_as_float(raw.z & 0xffff0000u) * rqv * g1[1] * k1[1]);
            w.w = pk_bf16_m(__uint_as_float(raw.w << 16) * rqv * g1[2] * k1[2], __uint_as_float(raw.w & 0xffff0000u) * rqv * g1[3] * k1[3]);
            Qf[s] = __builtin_bit_cast(b8, w); }
        v16f Oacc[4];
#pragma unroll
        for (int db = 0; db < 4; ++db)
#pragma unroll
            for (int i = 0; i < 16; ++i) Oacc[db][i] = 0.f;
        float lsum = 0.f;
        const int ntile = lat ? 24 : 8, qc = 32 * qh + r32, cstart = qc - 8 < 0 ? 0 : (qc - 8 > 48 ? 48 : qc - 8);
        for (int kt = 0; kt < ntile; ++kt) {
            const bool win = lat && kt < 16;
            const int krow0 = win ? b * 4096 + 64 * rstart + 32 * kt : ML + b * 256 + 32 * (lat ? kt - 16 : kt);
            const bf16* kp = qkv + (size_t)(krow0 + r32) * 6144 + 2048 + 128 * hd + 8 * h;
            v16f sacc;
#pragma unroll
            for (int i = 0; i < 16; ++i) sacc[i] = 0.f;
#pragma unroll
            for (int s = 0; s < 8; ++s) { const b8 Kf = *(const b8*)(kp + 16 * s); sacc = MFMA32(Kf, Qf[s], sacc); }
            const float* rkp = qkss + (size_t)(16 + hd) * MT + krow0 + 4 * h;
            const float* bp = rpb + (size_t)(hd * 15 + (rstart + (kt >> 1) - r + 7)) * 31 + 15 - qc + 32 * (kt & 1);
            float p[16];
#pragma unroll
            for (int i4 = 0; i4 < 4; ++i4) { const v4f rk = *(const v4f*)(rkp + 8 * i4);
#pragma unroll
                for (int j = 0; j < 4; ++j) { const int key = 8 * i4 + 4 * h + j; const float sc = sacc[4 * i4 + j] * rsqrtf(rk[j] * (1.0f / 128.0f) + RMS_EPS);
                    float pv;
                    if (win) { const int kc = 32 * (kt & 1) + key; const bool valid = (unsigned)(kc - cstart) < 16u; const float bias = valid ? bp[key] : 0.f; pv = valid ? __expf(sc + bias) : 0.f; }
                    else pv = __expf(sc);
                    p[4 * i4 + j] = pv; lsum += pv; } }
            const bf16* vp = qkv + (size_t)krow0 * 6144 + 4096 + 128 * hd + r32;
#pragma unroll
            for (int s2 = 0; s2 < 2; ++s2) {
                v4u pw; pw.x = pk_bf16_m(p[8 * s2 + 0], p[8 * s2 + 1]); pw.y = pk_bf16_m(p[8 * s2 + 2], p[8 * s2 + 3]); pw.z = pk_bf16_m(p[8 * s2 + 4], p[8 * s2 + 5]); pw.w = pk_bf16_m(p[8 * s2 + 6], p[8 * s2 + 7]);
                const b8 Pf = __builtin_bit_cast(b8, pw);
#pragma unroll
                for (int db = 0; db < 4; ++db) { b8 Vf;
#pragma unroll
                    for (int j = 0; j < 8; ++j) { const int key = 16 * s2 + 8 * (j >> 2) + 4 * h + (j & 3); Vf[j] = (short)vp[(size_t)key * 6144 + 32 * db]; }
                    Oacc[db] = MFMA32(Vf, Pf, Oacc[db]); } }
        }
        lsum += __shfl_xor(lsum, 32);
        const float inv = 1.0f / lsum;
        bf16* op = o + (size_t)qrow * D + 128 * hd + 4 * h;
#pragma unroll
        for (int db = 0; db < 4; ++db)
#pragma unroll
            for (int i4 = 0; i4 < 4; ++i4) { v2u w; w.x = pk_bf16(Oacc[db][4 * i4 + 0] * inv, Oacc[db][4 * i4 + 1] * inv); w.y = pk_bf16(Oacc[db][4 * i4 + 2] * inv, Oacc[db][4 * i4 + 3] * inv);
                *(v2u*)(op + 32 * db + 8 * i4) = w; }
    }
}

__device__ __forceinline__ void scan_phase(const bf16* ub, const float* a_re, const float* a_im, const float* log_dt, const float* b_re, const float* b_im, const float* c_re, const float* c_im,
                                           float* ybuf, LAS unsigned char* lds, int blk, int G, int wave, int lane) {
    OPAQUE_V(lane);
    if (wave >= 2) return;
    LAS float* BU = (LAS float*)(lds + wave * 32768);
    LAS unsigned char* HS = lds + wave * 32768 + 16384;
    LAS unsigned short* BB = (LAS unsigned short*)(lds + wave * 32768 + 16384 + 8704);
    const int h = lane >> 5, r32 = lane & 31, p = lane, ch = lane & 15, l4 = lane >> 4;
    for (int chain = blk * 2 + wave; chain < 512; chain += 2 * G) {
        const int dir = chain & 1, g = (chain >> 1) & 127, b = chain >> 8, dg = dir * 128 + g;
        const float lr = a_re[(size_t)dg * 64 + p], li = a_im[(size_t)dg * 64 + p], dt = expf(log_dt[dg]);
        const float er = expf(lr * dt), ar = er * cosf(li * dt), ai = er * sinf(li * dt);
        { const float nr = ar - 1.0f, ni = ai, den = 1.0f / (lr * lr + li * li), cr = (nr * lr + ni * li) * den, ci = (ni * lr - nr * li) * den;
          const float* brp = b_re + ((size_t)dg * 64 + p) * 16; const float* bip = b_im + ((size_t)dg * 64 + p) * 16;
#pragma unroll
          for (int c4 = 0; c4 < 4; ++c4) { const v4f br = *(const v4f*)(brp + 4 * c4), bi = *(const v4f*)(bip + 4 * c4);
              v2u wr_, wi_; wr_.x = pk_bf16(cr * br[0] - ci * bi[0], cr * br[1] - ci * bi[1]); wr_.y = pk_bf16(cr * br[2] - ci * bi[2], cr * br[3] - ci * bi[3]);
              wi_.x = pk_bf16(cr * bi[0] + ci * br[0], cr * bi[1] + ci * br[1]); wi_.y = pk_bf16(cr * bi[2] + ci * br[2], cr * bi[3] + ci * br[3]);
              *(LAS v2u*)(BB + (p * 2 + 0) * 16 + 4 * c4) = wr_; *(LAS v2u*)(BB + (p * 2 + 1) * 16 + 4 * c4) = wi_; } }
        LDS_WAIT(); asm volatile("" ::: "memory");
        b8 Bf[4];
#pragma unroll
        for (int cb = 0; cb < 4; ++cb) Bf[cb] = *(const LAS b8*)(BB + ((16 * cb + (r32 >> 1)) * 2 + (r32 & 1)) * 16 + 8 * h);
        b8 Cf[4];
#pragma unroll
        for (int ks = 0; ks < 4; ++ks) { const v4f cre = *(const v4f*)(c_re + ((size_t)dg * 16 + ch) * 64 + 16 * ks + 4 * l4), cim = *(const v4f*)(c_im + ((size_t)dg * 16 + ch) * 64 + 16 * ks + 4 * l4);
            v4u w; w.x = pk_bf16_m(cre[0], -cim[0]); w.y = pk_bf16_m(cre[1], -cim[1]); w.z = pk_bf16_m(cre[2], -cim[2]); w.w = pk_bf16_m(cre[3], -cim[3]); Cf[ks] = __builtin_bit_cast(b8, w); }
        float hr = 0.f, hi = 0.f;
        for (int bi_ = 0; bi_ < 136; ++bi_) {
            int rb, sg;
            if (dir == 0) { rb = bi_ < 8 ? ML + b * 256 + 32 * bi_ : b * 4096 + 32 * (bi_ - 8); sg = 1; }
            else { rb = bi_ < 8 ? ML + b * 256 + 255 - 32 * bi_ : b * 4096 + 4095 - 32 * (bi_ - 8); sg = -1; }
            const b8 Uf = *(const b8*)(ub + (size_t)(rb + sg * r32) * D + 16 * g + 8 * h);
#pragma unroll
            for (int cb = 0; cb < 4; ++cb) { v16f z;
#pragma unroll
                for (int i = 0; i < 16; ++i) z[i] = 0.f;
                const v16f dacc = MFMA32(Uf, Bf[cb], z);
#pragma unroll
                for (int i = 0; i < 16; ++i) BU[((i & 3) + 8 * (i >> 2) + 4 * h) * 128 + 32 * cb + r32] = dacc[i]; }
            LDS_WAIT(); asm volatile("" ::: "memory");
            v2f bu[32];
#pragma unroll
            for (int i = 0; i < 32; ++i) bu[i] = *(const LAS v2f*)(BU + i * 128 + 2 * p);
#pragma unroll
            for (int i = 0; i < 32; ++i) { const float nr = ar * hr - ai * hi + bu[i][0], ni = ar * hi + ai * hr + bu[i][1]; hr = nr; hi = ni;
                *(LAS unsigned*)(HS + i * 272 + 4 * p) = pk_bf16(hr, hi); }
            LDS_WAIT(); asm volatile("" ::: "memory");
#pragma unroll
            for (int tb = 0; tb < 2; ++tb) { v4f ya = {0.f, 0.f, 0.f, 0.f};
#pragma unroll
                for (int ks = 0; ks < 4; ++ks) { const b8 Hf = *(const LAS b8*)(HS + (16 * tb + ch) * 272 + (32 * ks + 8 * l4) * 2); ya = MFMA16(Cf[ks], Hf, ya); }
                const int row = rb + sg * (16 * tb + ch);
                *(v4f*)(ybuf + ((size_t)dir * MT + row) * D + 16 * g + 4 * l4) = ya; }
        }
    }
}
__device__ __forceinline__ void s5post_phase(const bf16* ub, const float* ybuf, const float* cd, bf16* xg, int M, int gw, int NGW, int lane) {
    OPAQUE_V(lane);
    for (int row = gw; row < M; row += NGW) {
        const v2u* up = (const v2u*)(ub + (size_t)row * D) + lane; const v4f* yf = (const v4f*)(ybuf + (size_t)row * D) + lane; const v4f* yr = (const v4f*)(ybuf + ((size_t)MT + row) * D) + lane;
        const v4f* dp = (const v4f*)cd + lane; v2u* o = (v2u*)(xg + (size_t)row * D) + lane;
#pragma unroll
        for (int j = 0; j < 8; ++j) { const v2u uu = up[64 * j]; const v4f d = dp[64 * j], a = yf[64 * j], c = yr[64 * j];
            const float y0 = d[0] * __uint_as_float(uu.x << 16) + a[0] + c[0], y1 = d[1] * __uint_as_float(uu.x & 0xffff0000u) + a[1] + c[1];
            const float y2 = d[2] * __uint_as_float(uu.y << 16) + a[2] + c[2], y3 = d[3] * __uint_as_float(uu.y & 0xffff0000u) + a[3] + c[3];
            v2u w; w.x = pk_bf16(pg8::fgelu(y0), pg8::fgelu(y1)); w.y = pk_bf16(pg8::fgelu(y2), pg8::fgelu(y3)); o[64 * j] = w; }
    }
}

__global__ void __launch_bounds__(NTHR, 2) fwd_kernel(Args a) {
    extern __shared__ __attribute__((aligned(16))) unsigned char lds_raw[];
    LAS unsigned char* lds = (LAS unsigned char*)lds_raw;
    volatile LAS unsigned* MISC = (volatile LAS unsigned*)(lds + MISC_OFF);
    const int tid = threadIdx.x, lane = tid & 63, wave = __builtin_amdgcn_readfirstlane(tid >> 6);
    const int G = gridDim.x, bx = blockIdx.x, vcu = (G % 8 == 0) ? (bx % 8) * (G / 8) + bx / 8 : bx;
    const int gw = vcu * NWAVES + wave, NGW = G * NWAVES;
    for (int u = tid; u < (LDS_BYTES - 131072) / 4; u += NTHR) ((LAS unsigned*)(lds + 131072))[u] = 0u;
    __syncthreads();
    unsigned char* ws = a.ws;
    XcdBarrier bar = xcd_barrier_post((unsigned*)(ws + WS_CTL) + CW_BAR + a.li * BAR_STRIDE, MISC + 8);
    const int lo = a.ph_lo, hi = a.ph_hi;
    int pc = 0;
#define PH_IN (lo <= pc && pc < hi)
#define PH_END() do { if (pc + 1 < hi) xcd_barrier(bar); } while (0)
    float* mod = (float*)(ws + WS_MOD); float* hc = (float*)(ws + WS_HC);
    bf16* xn = (bf16*)(ws + WS_XN); bf16* act = (bf16*)(ws + WS_ACT); float* ybuf = (float*)(ws + WS_Y);
    float* vss = (float*)(ws + WS_VSS); float* qkss = (float*)(ws + WS_QKSS);

    if (PH_IN) { if (!NO_P0) p0_prologue(a, lds, gw, NGW, tid, lane, wave); PH_END(); } ++pc;

    for (int f = 0; f < 8; ++f) {
        const int layer = f >> 1, sub = f & 1, kind = layer % 3, M = (layer == 3) ? ML : MT;
        const float* modl = mod + (size_t)layer * 3 * MODW;
        const float* hin_l = (f == 0) ? a.in[0] : (const float*)a.out; const float* hin_c = (f == 0) ? a.in[2] : (const float*)hc;
        if (PH_IN) { norm_phase(hin_l, hin_c, a.in[6] + (size_t)(layer * 3 + 2 * sub) * D, modl, 2 * sub, xn, M, gw, NGW, lane); PH_END(); } ++pc;
        if (PH_IN) { pg8::Gemm g{xn, (const bf16*)(ws + WS_WGU) + (size_t)f * 11264 * 2048, M, 11264, 2048}; pg8::StaticOrder S; S.init(M, 11264, G, bx);
            pg8::EpiSwiglu E{act, DFF}; pg8::gemm_phase<pg8::EpiSwiglu, pg8::StaticOrder, true, true>(lds, g, S, E); PH_END(); } ++pc;
        if (PH_IN) { pg8::Gemm g{act, (const bf16*)(ws + WS_WDN) + (size_t)f * 2048 * 5632, M, 2048, DFF}; pg8::StaticOrder S; S.init(M, 2048, G, bx);
            pg8::EpiRes E{hin_l, hin_c, a.out, hc, modl + (6 * sub + 2) * D, 0.5f}; pg8::gemm_phase<pg8::EpiRes, pg8::StaticOrder, true, true>(lds, g, S, E); PH_END(); } ++pc;
        if (sub == 0) {
            const int j = layer / 3;
            if (PH_IN) { norm_phase(a.out, hc, a.in[6] + (size_t)(layer * 3 + 1) * D, modl, 1, xn, M, gw, NGW, lane); PH_END(); } ++pc;
            if (kind == 0) {
                if (PH_IN) { pg8::Gemm g{xn, (const bf16*)(ws + WS_AWIN) + (size_t)j * 4096 * 2048, M, 4096, 2048}; pg8::StaticOrder S; S.init(M, 4096, G, bx);
                    pg8::EpiBf<1> E{act, 4096, vss + (size_t)j * MT}; pg8::gemm_phase<pg8::EpiBf<1>, pg8::StaticOrder, true, true>(lds, g, S, E); PH_END(); } ++pc;
                if (PH_IN) { if (!NO_SPAT) spatial_phase(act, vss + (size_t)j * MT, (const bf16*)(ws + WS_AWS) + (size_t)j * 16 * 128 * 128, a.in[10] + (size_t)j * D, a.in[12] + (size_t)j * 16 * 128, xn, M / 128, lds, vcu, G, tid, lane, wave); PH_END(); } ++pc;
            } else if (kind == 1) {
                if (PH_IN) { pg8::Gemm g{xn, (const bf16*)(ws + WS_BQKV), M, 6144, 2048}; pg8::StaticOrder S; S.init(M, 6144, G, bx);
                    pg8::EpiBf<2> E{act, 6144, qkss}; pg8::gemm_phase<pg8::EpiBf<2>, pg8::StaticOrder, true, true>(lds, g, S, E); PH_END(); } ++pc;
                if (PH_IN) { if (!NO_ATTN) attn_phase(act, qkss, a.in[15], a.in[16], a.in[17], xn, gw, NGW, lane); PH_END(); } ++pc;
            } else {
                if (PH_IN) { pg8::Gemm g{xn, (const bf16*)(ws + WS_CWIN), M, 2048, 2048}; pg8::StaticOrder S; S.init(M, 2048, G, bx);
                    pg8::EpiBf<0> E{act, 2048, nullptr}; pg8::gemm_phase<pg8::EpiBf<0>, pg8::StaticOrder, true, true>(lds, g, S, E); PH_END(); } ++pc;
                if (PH_IN) { if (!NO_SCAN) scan_phase(act, a.in[20], a.in[21], a.in[22], a.in[23], a.in[24], a.in[25], a.in[26], ybuf, lds, bx, G, wave, lane); PH_END(); } ++pc;
                if (PH_IN) { s5post_phase(act, ybuf, a.in[27], xn, M, gw, NGW, lane); PH_END(); } ++pc;
            }
            if (kind != 2) {
                if (PH_IN) { const bf16* wo = kind == 0 ? (const bf16*)(ws + WS_AWOUT) + (size_t)j * 2048 * 2048 : (const bf16*)(ws + WS_BWO);
                    pg8::Gemm g{xn, wo, M, 2048, 2048}; pg8::StaticOrder S; S.init(M, 2048, G, bx);
                    pg8::EpiRes E{a.out, hc, a.out, hc, modl + 5 * D, 1.0f}; pg8::gemm_phase<pg8::EpiRes, pg8::StaticOrder, true, true>(lds, g, S, E); PH_END(); } ++pc;
            } else {
                if (PH_IN) { pg8::Gemm g{xn, (const bf16*)(ws + WS_CGLU), M, 4096, 2048}; pg8::StaticOrder S; S.init(M, 4096, G, bx);
                    pg8::EpiGluRes E{a.out, hc, a.out, hc, modl + 5 * D}; pg8::gemm_phase<pg8::EpiGluRes, pg8::StaticOrder, true, true>(lds, g, S, E); PH_END(); } ++pc;
            }
        }
    }
#undef PH_IN
#undef PH_END
}

extern "C" void kernel_launch(void* const* d_in, const int* in_sizes, int n_in, void* d_out, int out_size, void* d_ws, size_t ws_size, hipStream_t stream) {
    static int grid = 0;
    if (grid == 0) {
        if (n_in != 29 || out_size != ML * D || ws_size < WS_END) { fprintf(stderr, "kernel_launch: unexpected shapes (n_in %d out %d ws %zu)\n", n_in, out_size, ws_size); grid = -1; return; }
        int dev = 0, cus = 0, per_cu = 0;
        if (hipGetDevice(&dev) != hipSuccess || hipDeviceGetAttribute(&cus, hipDeviceAttributeMultiprocessorCount, dev) != hipSuccess) { grid = -1; return; }
        if (hipFuncSetAttribute((const void*)fwd_kernel, hipFuncAttributeMaxDynamicSharedMemorySize, LDS_BYTES) != hipSuccess) { fprintf(stderr, "kernel_launch: hipFuncSetAttribute failed\n"); grid = -1; return; }
        if (hipOccupancyMaxActiveBlocksPerMultiprocessor(&per_cu, (const void*)fwd_kernel, NTHR, LDS_BYTES) != hipSuccess || per_cu < 1) fprintf(stderr, "kernel_launch: occupancy query says %d blocks per CU\n", per_cu);
        (void)hipGetLastError();
        grid = cus;
    }
    if (grid < 0) return;
    if (hipMemsetAsync(d_ws, 0, ZERO_BYTES, stream) != hipSuccess) { fprintf(stderr, "kernel_launch: memset failed\n"); return; }
    Args a{};
    for (int i = 0; i < 29; ++i) a.in[i] = (const float*)d_in[i];
    a.out = (float*)d_out; a.ws = (unsigned char*)d_ws; a.pad = 0;
#if MK_ONE_LAUNCH
    a.ph_lo = 0; a.ph_hi = NPHASES; a.li = 0;
    hipLaunchKernelGGL(fwd_kernel, dim3(grid), dim3(NTHR), LDS_BYTES, stream, a);
#else
    for (int k = 0; k < NPHASES; ++k) { a.ph_lo = k; a.ph_hi = k + 1; a.li = k;
        hipLaunchKernelGGL(fwd_kernel, dim3(grid), dim3(NTHR), LDS_BYTES, stream, a); }
#endif
    const hipError_t le = hipPeekAtLastError();
    if (le != hipSuccess) fprintf(stderr, "kernel_launch: launch failed: %s\n", hipGetErrorName(le));
}
```

```cpp
#include <hip/hip_runtime.h>
#include <cstdio>
#include <cstdint>
namespace pg8 {
#define PG8_LAS __attribute__((address_space(3)))
typedef unsigned short bf16_t;
typedef short bf16x8 __attribute__((ext_vector_type(8)));
typedef float f32x4 __attribute__((ext_vector_type(4)));
typedef unsigned u32x4 __attribute__((ext_vector_type(4)));
constexpr int BM = 256, BK = 64, HALF = 128, HTB = HALF * BK * 2  , STAGE_BYTES = 8 * HTB, NXCD = 8, WGM = 8;

__host__ __device__ __forceinline__ int lds_byte(int r, int c) { const int st = (r >> 4) * 2 + (c >> 5), rr = r & 15, cc = c & 31, ob = rr * 64 + cc * 2; return st * 1024 + (ob ^ (((ob >> 9) & 1) << 5)); }
__host__ __device__ __forceinline__ void stage_rc(int b, int& R, int& C) { const int st = b / 1024, sb = b % 1024, swz = sb ^ (((sb >> 9) & 1) << 5); R = (st >> 1) * 16 + swz / 64; C = (st & 1) * 32 + (swz % 64) / 2; }
__host__ __device__ __forceinline__ int perm32(int rho) { const int n = rho >> 4, i = rho & 15; return 8 * (i >> 2) + 4 * n + (i & 3); }

struct Unit { int pm, pn, kt0, nkt, part; };
struct Gemm { const bf16_t* A; const bf16_t* Bt; int M, N, K; };

struct StaticOrder {
    int nM, nN, nwg, G, c, nkt;
    __host__ __device__ void init(int M, int N, int K, int G_, int c_) { nM = M / BM; nN = N / BM; nwg = nM * nN; G = G_; c = c_; nkt = K / BK; }
    __host__ __device__ bool next(int i, Unit& u) const {
        const long L = (long)i * G + c; if (L >= nwg) return false;
        int wgid = (int)L; { const int q = nwg / NXCD, r = nwg % NXCD, xcd = wgid % NXCD, off = wgid / NXCD; wgid = (xcd < r ? xcd * (q + 1) : r * (q + 1) + (xcd - r) * q) + off; }
        const int nig = WGM * nN, gid = wgid / nig, fm = gid * WGM, gsz = (nM - fm) < WGM ? (nM - fm) : WGM;
        u.pm = fm + ((wgid % nig) % gsz); u.pn = (wgid % nig) / gsz; u.kt0 = 0; u.nkt = nkt; u.part = 0; return true;
    }
    __device__ __forceinline__ void a_ready(const Unit&) const {}
    __device__ __forceinline__ void done(const Unit&) const {}
};
struct SplitOrder {
    StaticOrder lat; int nlat, npiece, nN, nkt, split, G, c;
    __device__ void init(int N, int K, int G_, int c_, int split_, bool has_ctx) { lat.init(8192, N, K, G_, c_); nN = N / BM; nkt = K / BK; split = split_; nlat = 32 * nN; npiece = has_ctx ? 2 * nN * split_ : 0; G = G_; c = c_; }
    __device__ bool next(int i, Unit& u) const {
        const long L = (long)i * G + c;
        if (L < nlat) return lat.next(i, u);
        const int q = (int)(L - nlat); if (q >= npiece) return false;
        const int cu = q / split, s = q - cu * split, PP = nkt >> 1, p0 = s * PP / split, p1 = (s + 1) * PP / split;
        u.pm = 32 + cu / nN; u.pn = cu % nN; u.kt0 = 2 * p0; u.nkt = 2 * (p1 - p0); u.part = 1 + s; return true;
    }
    __device__ __forceinline__ void a_ready(const Unit&) const {}
    __device__ __forceinline__ void done(const Unit&) const {}
};
__device__ __forceinline__ unsigned cvt_pk_bf16(float lo, float hi) { unsigned r; asm volatile("v_cvt_pk_bf16_f32 %0, %1, %2" : "=v"(r) : "v"(lo), "v"(hi)); return r; }
__device__ __forceinline__ float fsigmoid(float x) { return __builtin_amdgcn_rcpf(1.0f + __builtin_amdgcn_exp2f(-1.44269504f * x)); }
__device__ __forceinline__ float fsilu(float x) { return x * fsigmoid(x); }
__device__ __forceinline__ float fgelu(float x) { return x * fsigmoid(1.5957691216f * (x + 0.044715f * x * x * x)); }
constexpr int ROWS_LAT = 8192, ROWS_ALL = 8704, MODW = 9 * 2048;

struct EpiSwiglu {
    static constexpr bool PERM = true, AFTER_DRAIN = false;
    bf16_t* O; int ldc;
    __device__ __forceinline__ void operator()(const f32x4 (&acc)[2][2][4][2], const Unit& u, int wr, int wc, int fr, int fq) const {
        const int row0 = u.pm * BM + wr * 64 + fr, col0 = u.pn * HALF + wc * 32 + 8 * fq;
#pragma unroll
        for (int ai = 0; ai < 2; ++ai)
#pragma unroll
            for (int m = 0; m < 4; ++m) { bf16_t* rowp = O + (size_t)(row0 + ai * HALF + m * 16) * ldc + col0;
                const f32x4 g0 = acc[ai][0][m][0], g1 = acc[ai][0][m][1], u0 = acc[ai][1][m][0], u1 = acc[ai][1][m][1];
                u32x4 w; w.x = cvt_pk_bf16(fsilu(g0[0]) * u0[0], fsilu(g0[1]) * u0[1]); w.y = cvt_pk_bf16(fsilu(g0[2]) * u0[2], fsilu(g0[3]) * u0[3]);
                w.z = cvt_pk_bf16(fsilu(g1[0]) * u1[0], fsilu(g1[1]) * u1[1]); w.w = cvt_pk_bf16(fsilu(g1[2]) * u1[2], fsilu(g1[3]) * u1[3]);
                *(u32x4*)rowp = w; }
    }
};
struct EpiRes {
    static constexpr bool PERM = false, AFTER_DRAIN = false;
    const float* blat; const float* bctx; float* olat; float* octx; const float* gate; float* slab; float f;
    __device__ __forceinline__ void operator()(const f32x4 (&acc)[2][2][4][2], const Unit& u, int wr, int wc, int fr, int fq) const {
        const bool isctx = u.pm >= 32; const int cls = isctx ? 2 : (u.pm >> 4);
        const float* base = isctx ? bctx : blat; float* out = isctx ? octx : olat;
        const int row0 = (isctx ? u.pm - 32 : u.pm) * BM + wr * 64 + fr, col0 = u.pn * BM + wc * 32 + 4 * fq;
        const float* gp = gate + cls * MODW + col0;
        f32x4 gv[2][2];
#pragma unroll
        for (int bj = 0; bj < 2; ++bj)
#pragma unroll
            for (int n = 0; n < 2; ++n) gv[bj][n] = *(const f32x4*)(gp + bj * HALF + n * 16) * f;
#pragma unroll
        for (int ai = 0; ai < 2; ++ai)
#pragma unroll
            for (int m = 0; m < 4; ++m) { const size_t off = (size_t)(row0 + ai * HALF + m * 16) * 2048 + col0;
#pragma unroll
                for (int bj = 0; bj < 2; ++bj)
#pragma unroll
                    for (int n = 0; n < 2; ++n) {
                        if (u.part) *(f32x4*)(slab + (size_t)(u.part - 1) * (512 * 2048) + off + bj * HALF + n * 16) = gv[bj][n] * acc[ai][bj][m][n];
                        else { const f32x4 b = *(const f32x4*)(base + off + bj * HALF + n * 16); *(f32x4*)(out + off + bj * HALF + n * 16) = b + gv[bj][n] * acc[ai][bj][m][n]; } } }
    }
};
struct EpiGluRes {
    static constexpr bool PERM = false, AFTER_DRAIN = false;
    const float* blat; const float* bctx; float* olat; float* octx; const float* gate;
    __device__ __forceinline__ void operator()(const f32x4 (&acc)[2][2][4][2], const Unit& u, int wr, int wc, int fr, int fq) const {
        const bool isctx = u.pm >= 32; const int cls = isctx ? 2 : (u.pm >> 4);
        const float* base = isctx ? bctx : blat; float* out = isctx ? octx : olat;
        const int row0 = (isctx ? u.pm - 32 : u.pm) * BM + wr * 64 + fr, col0 = u.pn * HALF + wc * 32 + 4 * fq;
        const float* gp = gate + cls * MODW + col0;
        f32x4 gv[2];
#pragma unroll
        for (int n = 0; n < 2; ++n) gv[n] = *(const f32x4*)(gp + n * 16);
#pragma unroll
        for (int ai = 0; ai < 2; ++ai)
#pragma unroll
            for (int m = 0; m < 4; ++m) { const size_t off = (size_t)(row0 + ai * HALF + m * 16) * 2048 + col0;
#pragma unroll
                for (int n = 0; n < 2; ++n) { const f32x4 b = *(const f32x4*)(base + off + n * 16); const f32x4 av = acc[ai][0][m][n], gg = acc[ai][1][m][n];
                    f32x4 v; v[0] = av[0] * fsigmoid(gg[0]); v[1] = av[1] * fsigmoid(gg[1]); v[2] = av[2] * fsigmoid(gg[2]); v[3] = av[3] * fsigmoid(gg[3]);
                    *(f32x4*)(out + off + n * 16) = b + gv[n] * v; } }
    }
};
template <int MODE> struct EpiBf {
    static constexpr bool PERM = true, AFTER_DRAIN = false;
    bf16_t* O; int ldc; float* ss;
    __device__ __forceinline__ void operator()(const f32x4 (&acc)[2][2][4][2], const Unit& u, int wr, int wc, int fr, int fq) const {
        const int row0 = u.pm * BM + wr * 64 + fr, col0 = u.pn * BM + wc * 32 + 8 * fq;
#pragma unroll
        for (int ai = 0; ai < 2; ++ai)
#pragma unroll
            for (int m = 0; m < 4; ++m) { const int row = row0 + ai * HALF + m * 16; bf16_t* rowp = O + (size_t)row * ldc + col0; float s1 = 0.f;
#pragma unroll
                for (int bj = 0; bj < 2; ++bj) { f32x4 v0 = acc[ai][bj][m][0], v1 = acc[ai][bj][m][1];
                    if (MODE == 1) {
#pragma unroll
                        for (int j = 0; j < 4; ++j) { v0[j] = fgelu(v0[j]); v1[j] = fgelu(v1[j]); } }
                    u32x4 w; w.x = cvt_pk_bf16(v0[0], v0[1]); w.y = cvt_pk_bf16(v0[2], v0[3]); w.z = cvt_pk_bf16(v1[0], v1[1]); w.w = cvt_pk_bf16(v1[2], v1[3]);
                    *(u32x4*)(rowp + bj * HALF) = w;
                    if (MODE != 0) { float s = (v0[0] * v0[0] + v0[1] * v0[1]) + (v0[2] * v0[2] + v0[3] * v0[3]) + (v1[0] * v1[0] + v1[1] * v1[1]) + (v1[2] * v1[2] + v1[3] * v1[3]);
                        if (MODE == 2) { if (u.pn < 16) { s += __shfl_xor(s, 16); s += __shfl_xor(s, 32); if (fq == 0) unsafeAtomicAdd(ss + (size_t)(2 * u.pn + bj) * ROWS_ALL + row, s); } }
                        else s1 += s; } }
                if (MODE == 1) { if (u.pn >= 8) { s1 += __shfl_xor(s1, 16); s1 += __shfl_xor(s1, 32); if (fq == 0) unsafeAtomicAdd(ss + row, s1); } } }
    }
};

template <class Epi, class Sched, bool ALIGN_EPI = false, bool SP2 = false>
__device__ __forceinline__ void gemm_phase(PG8_LAS unsigned char* lds, const Gemm g, const Sched& S, const Epi& E) {
    int tid_l = threadIdx.x; asm volatile("" : "+v"(tid_l));
    const int tid = tid_l, wid = __builtin_amdgcn_readfirstlane(tid >> 6), lane = tid & 63, wr = wid >> 2, wc = wid & 3, fr = lane & 15, fq = lane >> 4;
    const int K = g.K;
    unsigned voffA[2], voffB[2];
#pragma unroll
    for (int i = 0; i < 2; ++i) { int R, C; stage_rc(tid * 16 + i * 8192, R, C); const int Rb = Epi::PERM ? ((R & ~31) + perm32(R & 31)) : R;
        voffA[i] = (unsigned)(R * K + C) * 2u; voffB[i] = (unsigned)(Rb * K + C) * 2u; }
    const size_t kstep = (size_t)(BK * 2);
    const size_t hstep = (size_t)HALF * K * 2;
    const size_t tstep = 2 * hstep;
    const unsigned ldsw = (unsigned)wid * 1024u;
    const int aoff = lds_byte(wr * 64 + fr, fq * 8), boff = lds_byte(wc * 32 + fr, fq * 8);
#define PG8_SA(b, h) (((b) * 2 + (h)) * HTB)
#define PG8_SB(b, h) ((4 + (b) * 2 + (h)) * HTB)
#define PG8_STAGE(bufoff, gbase, voff) do { _Pragma("unroll") for (int _i = 0; _i < 2; ++_i) \
        __builtin_amdgcn_global_load_lds((const unsigned*)((const char*)(gbase) + (voff)[_i]), (PG8_LAS unsigned*)(lds + (bufoff) + ldsw + _i * 8192), 16, 0, 0); } while (0)
#define PG8_LDA(dst, b, h) do { _Pragma("unroll") for (int m = 0; m < 4; ++m) _Pragma("unroll") for (int k = 0; k < 2; ++k) dst[m][k] = *(const PG8_LAS bf16x8*)(lds + PG8_SA(b, h) + aoff + m * 2048 + k * 1024); } while (0)
#define PG8_LDB(dst, b, h) do { _Pragma("unroll") for (int n = 0; n < 2; ++n) _Pragma("unroll") for (int k = 0; k < 2; ++k) dst[n][k] = *(const PG8_LAS bf16x8*)(lds + PG8_SB(b, h) + boff + n * 2048 + k * 1024); } while (0)
#define PG8_MMA(ai, bj, At, Bt) do { __builtin_amdgcn_s_setprio(1); _Pragma("unroll") for (int m = 0; m < 4; ++m) _Pragma("unroll") for (int n = 0; n < 2; ++n) _Pragma("unroll") for (int k = 0; k < 2; ++k) \
        acc[ai][bj][m][n] = __builtin_amdgcn_mfma_f32_16x16x32_bf16(Bt[n][k], At[m][k], acc[ai][bj][m][n], 0, 0, 0); __builtin_amdgcn_s_setprio(0); } while (0)
#define PG8_WAIT_V(n) asm volatile("s_waitcnt vmcnt(" #n ")" ::: "memory")
#define PG8_WAIT_L(n) asm volatile("s_waitcnt lgkmcnt(" #n ")" ::: "memory")
#define PG8_BAR __builtin_amdgcn_s_barrier()
#define PG8_SCHED __builtin_amdgcn_sched_barrier(0)
    Unit cur, nxt; int ui = 0;
    if (!S.next(0, cur)) return;
    f32x4 acc[2][2][4][2];
#pragma unroll
    for (int a = 0; a < 2; ++a)
#pragma unroll
        for (int b = 0; b < 2; ++b)
#pragma unroll
            for (int m = 0; m < 4; ++m)
#pragma unroll
                for (int n = 0; n < 2; ++n) acc[a][b][m][n] = (f32x4){0.f, 0.f, 0.f, 0.f};
    bf16x8 At[4][2], B0[2][2], B1[2][2];
    const char* cA = (const char*)g.A + (size_t)cur.pm * tstep + (size_t)cur.kt0 * kstep; const char* cB = (const char*)g.Bt + (size_t)cur.pn * tstep + (size_t)cur.kt0 * kstep;
    S.a_ready(cur);
    if constexpr (SP2) {
        PG8_STAGE(PG8_SB(0, 0), cB, voffB); PG8_STAGE(PG8_SB(0, 1), cB + hstep, voffB); PG8_STAGE(PG8_SA(0, 0), cA, voffA); PG8_STAGE(PG8_SA(0, 1), cA + hstep, voffA);
        if (wr == 1) PG8_BAR;
        PG8_WAIT_V(2); PG8_BAR;
        PG8_STAGE(PG8_SB(1, 0), cB + kstep, voffB); PG8_STAGE(PG8_SA(1, 0), cA + kstep, voffA); PG8_STAGE(PG8_SB(1, 1), cB + hstep + kstep, voffB);
        PG8_WAIT_V(6); PG8_BAR;
    } else {
        PG8_STAGE(PG8_SB(0, 0), cB, voffB); PG8_STAGE(PG8_SA(0, 0), cA, voffA); PG8_STAGE(PG8_SB(0, 1), cB + hstep, voffB); PG8_STAGE(PG8_SA(0, 1), cA + hstep, voffA);
        if (wr == 1) PG8_BAR;
        PG8_WAIT_V(4); PG8_BAR;
        PG8_STAGE(PG8_SB(1, 0), cB + kstep, voffB); PG8_STAGE(PG8_SA(1, 0), cA + kstep, voffA); PG8_STAGE(PG8_SB(1, 1), cB + hstep + kstep, voffB);
        PG8_WAIT_V(6); PG8_BAR;
    }
    for (;;) {
        const bool has_next = S.next(ui + 1, nxt);
        const char* nA = has_next ? (const char*)g.A + (size_t)nxt.pm * tstep + (size_t)nxt.kt0 * kstep : cA; const char* nB = has_next ? (const char*)g.Bt + (size_t)nxt.pn * tstep + (size_t)nxt.kt0 * kstep : cB;
        const int nt = cur.nkt;
        for (int t = 0; t < nt; t += 2) {
            const bool last = (t == nt - 2);
            const char* a1 = cA + (size_t)(t + 1) * kstep;
            const char* a2 = last ? nA : cA + (size_t)(t + 2) * kstep; const char* b2 = last ? nB : cB + (size_t)(t + 2) * kstep;
            const char* a3 = a2 + kstep; const char* b3 = b2 + kstep;
            if (last && has_next) S.a_ready(nxt);
            if constexpr (SP2) {
            PG8_LDB(B0, 0, 0); PG8_LDB(B1, 0, 1); PG8_SCHED; PG8_LDA(At, 0, 0); PG8_STAGE(PG8_SA(1, 1), a1 + hstep, voffA);
            PG8_WAIT_V(8); PG8_WAIT_L(0); PG8_BAR; PG8_MMA(0, 0, At, B0); PG8_MMA(0, 1, At, B1); PG8_BAR; PG8_SCHED;
            PG8_LDA(At, 0, 1); PG8_STAGE(PG8_SB(0, 0), b2, voffB); PG8_STAGE(PG8_SB(0, 1), b2 + hstep, voffB); PG8_STAGE(PG8_SA(0, 0), a2, voffA);
            PG8_WAIT_V(8); PG8_WAIT_L(0); PG8_BAR; PG8_MMA(1, 0, At, B0); PG8_MMA(1, 1, At, B1); PG8_BAR; PG8_SCHED;
            PG8_LDB(B0, 1, 0); PG8_LDB(B1, 1, 1); PG8_SCHED; PG8_LDA(At, 1, 0); PG8_STAGE(PG8_SA(0, 1), a2 + hstep, voffA);
            PG8_WAIT_V(8); PG8_WAIT_L(0); PG8_BAR; PG8_MMA(0, 0, At, B0); PG8_MMA(0, 1, At, B1); PG8_BAR; PG8_SCHED;
            PG8_LDA(At, 1, 1); PG8_STAGE(PG8_SB(1, 0), b3, voffB); PG8_STAGE(PG8_SB(1, 1), b3 + hstep, voffB); PG8_STAGE(PG8_SA(1, 0), a3, voffA);
            PG8_WAIT_V(8); PG8_WAIT_L(0); PG8_BAR; PG8_MMA(1, 0, At, B0); PG8_MMA(1, 1, At, B1); PG8_BAR; PG8_SCHED;
            } else {
            PG8_LDB(B0, 0, 0); PG8_SCHED; PG8_LDA(At, 0, 0); PG8_STAGE(PG8_SA(1, 1), a1 + hstep, voffA);
            PG8_WAIT_L(8); PG8_BAR; PG8_WAIT_L(0); PG8_MMA(0, 0, At, B0); PG8_BAR; PG8_SCHED;
            PG8_LDB(B1, 0, 1); PG8_STAGE(PG8_SB(0, 0), b2, voffB);
            PG8_BAR; PG8_WAIT_L(0); PG8_MMA(0, 1, At, B1); PG8_BAR;
            PG8_LDA(At, 0, 1); PG8_STAGE(PG8_SA(0, 0), a2, voffA);
            PG8_BAR; PG8_WAIT_L(0); PG8_MMA(1, 0, At, B0); PG8_BAR; PG8_SCHED;
            PG8_STAGE(PG8_SB(0, 1), b2 + hstep, voffB);
            PG8_WAIT_V(6); PG8_BAR; PG8_MMA(1, 1, At, B1); PG8_BAR;
            PG8_LDB(B0, 1, 0); PG8_SCHED; PG8_LDA(At, 1, 0); PG8_STAGE(PG8_SA(0, 1), a2 + hstep, voffA);
            PG8_WAIT_L(8); PG8_BAR; PG8_WAIT_L(0); PG8_MMA(0, 0, At, B0); PG8_BAR; PG8_SCHED;
            PG8_LDB(B1, 1, 1); PG8_STAGE(PG8_SB(1, 0), b3, voffB);
            PG8_BAR; PG8_WAIT_L(0); PG8_MMA(0, 1, At, B1); PG8_BAR;
            PG8_LDA(At, 1, 1); PG8_STAGE(PG8_SA(1, 0), a3, voffA);
            PG8_BAR; PG8_WAIT_L(0); PG8_MMA(1, 0, At, B0); PG8_BAR; PG8_SCHED;
            PG8_STAGE(PG8_SB(1, 1), b3 + hstep, voffB);
            PG8_WAIT_V(6); PG8_BAR; PG8_MMA(1, 1, At, B1); PG8_BAR;
            }
        }
        if constexpr (ALIGN_EPI) { if (wr == 0) PG8_BAR; }
        if constexpr (!Epi::AFTER_DRAIN) { E(acc, cur, wr, wc, fr, fq); S.done(cur); }
        if (!has_next) break;
#pragma unroll
        for (int a = 0; a < 2; ++a)
#pragma unroll
            for (int b = 0; b < 2; ++b)
#pragma unroll
                for (int m = 0; m < 4; ++m)
#pragma unroll
                    for (int n = 0; n < 2; ++n) acc[a][b][m][n] = (f32x4){0.f, 0.f, 0.f, 0.f};
        cur = nxt; cA = nA; cB = nB; ++ui;
        if constexpr (ALIGN_EPI) { if (wr == 1) PG8_BAR; }
    }
    PG8_WAIT_V(0);
    if constexpr (!ALIGN_EPI) { if (wr == 0) PG8_BAR; }
    PG8_BAR;
    if constexpr (Epi::AFTER_DRAIN) { E.fused(acc, cur, wr, wc, fr, fq, lds, wid, lane); S.done(cur); }
#undef PG8_SA
#undef PG8_SB
#undef PG8_STAGE
#undef PG8_LDA
#undef PG8_LDB
#undef PG8_MMA
#undef PG8_WAIT_V
#undef PG8_WAIT_L
#undef PG8_BAR
#undef PG8_SCHED
}
}
#define XB_TMO      128
#define XB_XCNT(j)  (256  + 64 * (j))
#define XB_XSUB(j)  (1280 + 64 * (j))
#define XB_XGEN(j)  (2304 + 64 * (j))
#define XB_TOP      3328
#define XB_TOPGEN   3392
#define XCD_BAR_WORDS 3456
#define XB_SPIN_CAP (1u << 18)
#define LAS __attribute__((address_space(3)))

__device__ __forceinline__ unsigned xb_ld(unsigned* p)              { return __hip_atomic_load(p, __ATOMIC_RELAXED, __HIP_MEMORY_SCOPE_AGENT); }
__device__ __forceinline__ unsigned xb_add(unsigned* p, unsigned v) { return __hip_atomic_fetch_add(p, v, __ATOMIC_RELAXED, __HIP_MEMORY_SCOPE_AGENT); }
__device__ __forceinline__ unsigned xb_xcc_id() { return (unsigned)__builtin_amdgcn_s_getreg((3 << 11) | 20) & 0xFu; }
#define XB_SPIN(cond, bar) do { unsigned _sp = 0; while (cond) { __builtin_amdgcn_s_sleep(1); \
    if ((++_sp & 255u) == 0u) { if (xb_ld(&(bar)[XB_TMO])) break; if (_sp > XB_SPIN_CAP) { atomicAdd(&(bar)[XB_TMO], 1u); break; } } } } while (0)

struct XcdBarrier {
    unsigned* bar; unsigned x;
    volatile LAS unsigned* st;
};

__device__ __forceinline__ XcdBarrier xcd_barrier_post(unsigned* bar, volatile LAS unsigned* st) {
    XcdBarrier b; b.bar = bar; b.x = xb_xcc_id(); b.st = st;
    if (threadIdx.x == 0) (void)xb_add(&bar[XB_XCNT(b.x)], 1u);
    return b;
}
__device__ __forceinline__ void xcd_barrier_complete(unsigned* bar, unsigned x, unsigned& nloc, unsigned& nx) {
    const unsigned G = gridDim.x * gridDim.y * gridDim.z;
    unsigned sum, cnt, mine, sp = 0u;
    for (;;) {
        sum = 0u; cnt = 0u; mine = 0u;
#pragma unroll
        for (unsigned j = 0; j < 16; ++j) { const unsigned c = xb_ld(&bar[XB_XCNT(j)]); sum += c; cnt += (c > 0u) ? 1u : 0u; mine = (j == x) ? c : mine; }
        if (sum == G) break;
        __builtin_amdgcn_s_sleep(1);
        if ((++sp & 255u) == 0u) { if (xb_ld(&bar[XB_TMO])) break; if (sp > XB_SPIN_CAP) { atomicAdd(&bar[XB_TMO], 1u); break; } }
    }
    nloc = mine > 0u ? mine : 1u; nx = cnt > 0u ? cnt : 1u;
}

__device__ __forceinline__ void xcd_barrier(const XcdBarrier& b) {
    asm volatile("s_waitcnt vmcnt(0)" ::: "memory");
    __syncthreads();
    if (threadIdx.x == 0) {
        unsigned* bar = b.bar;
        __builtin_amdgcn_s_waitcnt(0);
        unsigned nloc = b.st[0], nx = b.st[1];
        if (nloc == 0u) { xcd_barrier_complete(bar, b.x, nloc, nx); b.st[0] = nloc; b.st[1] = nx; }
        const unsigned old = xb_add(&bar[XB_XSUB(b.x)], 1u);
        const unsigned gen = old / nloc;
        if (old + 1u == (gen + 1u) * nloc) {
            __builtin_amdgcn_fence(__ATOMIC_RELEASE, "agent");
            asm volatile("s_waitcnt vmcnt(0)" ::: "memory");
            const unsigned og = xb_add(&bar[XB_TOP], 1u);
            const unsigned tg = og / nx;
            if (og + 1u == (tg + 1u) * nx) xb_add(&bar[XB_TOPGEN], 1u);
            else XB_SPIN(xb_ld(&bar[XB_TOPGEN]) == tg, bar);
            __builtin_amdgcn_fence(__ATOMIC_ACQUIRE, "agent");
            xb_add(&bar[XB_XGEN(b.x)], 1u);
            asm volatile("s_waitcnt vmcnt(0)" ::: "memory");
        } else {
            XB_SPIN(xb_ld(&bar[XB_XGEN(b.x)]) == gen, bar);
            __builtin_amdgcn_fence(__ATOMIC_ACQUIRE, "agent");
            asm volatile("s_waitcnt vmcnt(0)" ::: "memory");
        }
    }
    __syncthreads();
}
#define GAS __attribute__((address_space(1)))
typedef unsigned short bf16;
typedef float v4f __attribute__((ext_vector_type(4)));
typedef float v2f __attribute__((ext_vector_type(2)));
typedef float v16f __attribute__((ext_vector_type(16)));
typedef short b8 __attribute__((ext_vector_type(8)));
typedef unsigned v4u __attribute__((ext_vector_type(4)));
typedef unsigned v2u __attribute__((ext_vector_type(2)));
#define LDS_WAIT() asm volatile("s_waitcnt lgkmcnt(0)" ::: "memory")
#define MFMA32(a, b, c) __builtin_amdgcn_mfma_f32_32x32x16_bf16((a), (b), (c), 0, 0, 0)
#define MFMA16(a, b, c) __builtin_amdgcn_mfma_f32_16x16x32_bf16((a), (b), (c), 0, 0, 0)

using pg8::MODW;
constexpr int NWAVES = 8, NTHR = 512;
constexpr int D = 2048, DFF = 5632, ML = 8192, MC = 512, MT = 8704;
constexpr float RMS_EPS = 1e-6f;
#ifndef MK_ONE_LAUNCH
#define MK_ONE_LAUNCH 1
#endif
constexpr int NPHASES = 42;
#ifndef KSPLIT
#define KSPLIT 16
#endif
#ifndef NO_ATTN
#define NO_ATTN 0
#endif
#ifndef NO_SCAN
#define NO_SCAN 0
#endif
#ifndef NO_SPAT
#define NO_SPAT 0
#endif
#ifndef NO_P0
#define NO_P0 0
#endif

constexpr size_t MiB = 1u << 20;
constexpr size_t WS_CTL = 0;
constexpr size_t WS_VSS = 1 * MiB;
constexpr size_t WS_QKSS = 1 * MiB + 128 * 1024;
constexpr size_t WS_MOD = 3 * MiB;
constexpr size_t ZERO_BYTES = 4 * MiB;
constexpr size_t WS_HC = 4 * MiB;
constexpr size_t WS_XN = 8 * MiB;
constexpr size_t WS_ACT = 42 * MiB;
constexpr size_t WS_Y = 144 * MiB;
constexpr size_t WS_SLAB = 913 * MiB;
constexpr size_t WS_WGU = 280 * MiB, WS_WDN = 632 * MiB, WS_AWIN = 808 * MiB, WS_AWOUT = 840 * MiB, WS_AWS = 856 * MiB;
constexpr size_t WS_BQKV = 857 * MiB, WS_BWO = 881 * MiB, WS_CWIN = 889 * MiB, WS_CGLU = 897 * MiB, WS_END = 977 * MiB;
constexpr int CW_BAR = 4096, BAR_STRIDE = 3584;
static_assert((CW_BAR + 48 * BAR_STRIDE) * 4 <= (int)MiB, "ctl");
constexpr int LDS_BYTES = 147456;
constexpr int MISC_OFF = 131072 + 320;

__device__ __forceinline__ float bf2f(unsigned short b) { return __uint_as_float(((unsigned)b) << 16); }
__device__ __forceinline__ unsigned pk_bf16(float lo, float hi) { return pg8::cvt_pk_bf16(lo, hi); }
__device__ __forceinline__ unsigned pk_bf16_m(float lo, float hi) { unsigned r; asm volatile("v_cvt_pk_bf16_f32 %0, %1, %2\n\ts_nop 1" : "=v"(r) : "v"(lo), "v"(hi)); return r; }
__device__ __forceinline__ float wave_sum(float v) {
#pragma unroll
    for (int o = 1; o < 64; o <<= 1) v += __shfl_xor(v, o);
    return v;
}

#define OPAQUE_V(x) asm volatile("" : "+v"(x))
struct Args { const float* in[29]; float* out; unsigned char* ws; int ph_lo, ph_hi, li, pad; };

__device__ __forceinline__ void tr_item(const float* W, int K, int N, bf16* WT, int nh, int item, LAS float* scr, int lane) {
    const int nblk = N / 32, kb = item / nblk, nb = item - kb * nblk, k0 = 64 * kb, n0 = 32 * nb;
    int drow0 = n0; if (nh) { const int half = n0 >= nh ? 1 : 0, c = n0 - half * nh; drow0 = 256 * (c >> 7) + 128 * half + (c & 127); }
    const float* src = W + (size_t)k0 * N + n0 + (lane & 31) + (size_t)(lane >> 5) * N;
#pragma unroll 8
    for (int i = 0; i < 32; ++i) scr[(2 * i + (lane >> 5)) * 33 + (lane & 31)] = src[(size_t)(2 * i) * N];
    LDS_WAIT(); asm volatile("" ::: "memory");
    const int c = lane & 7;
#pragma unroll
    for (int j = 0; j < 4; ++j) { const int n = (lane >> 3) + 8 * j; const LAS float* s = scr + (8 * c) * 33 + n;
        v4u o; o.x = pk_bf16(s[0 * 33], s[1 * 33]); o.y = pk_bf16(s[2 * 33], s[3 * 33]); o.z = pk_bf16(s[4 * 33], s[5 * 33]); o.w = pk_bf16(s[6 * 33], s[7 * 33]);
        *(v4u*)(WT + (size_t)(drow0 + n) * K + k0 + 8 * c) = o; }
    LDS_WAIT(); asm volatile("" ::: "memory");
}
__device__ __forceinline__ void p0_prologue(const Args& a, LAS unsigned char* lds, int gw, int NGW, int tid, int lane, int wave) {
    OPAQUE_V(tid); OPAQUE_V(lane);
    LAS float* sl = (LAS float*)(lds + 73728);
    for (int i = tid; i < 3 * 2048; i += NTHR) { const float v = i < 4096 ? a.in[1][i] : a.in[3][i - 4096]; sl[i] = v / (1.0f + __expf(-v)); }
    __syncthreads();
    LAS float* scr = (LAS float*)(lds + wave * 8704);
    unsigned char* ws = a.ws;
    constexpr int I_ADA = 4 * 72 * 16, I_GU = 32 * 352, I_DN = 88 * 64, I_AIN = 32 * 128, I_SQ = 32 * 64, I_QKV = 32 * 192, I_WS = 256, I_HC = 256;
    constexpr int NITEMS = I_ADA + 8 * I_GU + 8 * I_DN + 2 * I_AIN + 2 * I_SQ + I_QKV + I_SQ + I_SQ + I_AIN + I_WS + I_HC;
    for (int it = gw; it < NITEMS; it += NGW) {
        int r = it;
        if (r < I_ADA) {
            const int layer = r / 1152, rr = r - layer * 1152, cb = rr >> 4, ks = rr & 15, n0 = cb * 256 + lane * 4, k0 = ks * 128;
            const float* Wp = a.in[4] + (size_t)layer * 2048 * MODW + (size_t)k0 * MODW + n0;
            v4f a0 = {0.f, 0.f, 0.f, 0.f}, a1 = a0, a2 = a0;
#pragma unroll 8
            for (int k = 0; k < 128; ++k) { const v4f w = *(const v4f*)(Wp + (size_t)k * MODW); a0 += w * sl[k0 + k]; a1 += w * sl[2048 + k0 + k]; a2 += w * sl[4096 + k0 + k]; }
            if (ks == 0) { const v4f bv = *(const v4f*)(a.in[5] + (size_t)layer * MODW + n0); a0 += bv; a1 += bv; a2 += bv; }
            float* mp = (float*)(ws + WS_MOD) + (size_t)layer * 3 * MODW + n0;
#pragma unroll
            for (int j = 0; j < 4; ++j) { unsafeAtomicAdd(mp + j, a0[j]); unsafeAtomicAdd(mp + MODW + j, a1[j]); unsafeAtomicAdd(mp + 2 * MODW + j, a2[j]); }
            continue; }
        r -= I_ADA;
        if (r < 8 * I_GU) { const int f = r / I_GU; tr_item(a.in[7] + (size_t)f * 2048 * 11264, 2048, 11264, (bf16*)(ws + WS_WGU) + (size_t)f * 11264 * 2048, 5632, r - f * I_GU, scr, lane); continue; } r -= 8 * I_GU;
        if (r < 8 * I_DN) { const int f = r / I_DN; tr_item(a.in[8] + (size_t)f * 5632 * 2048, 5632, 2048, (bf16*)(ws + WS_WDN) + (size_t)f * 2048 * 5632, 0, r - f * I_DN, scr, lane); continue; } r -= 8 * I_DN;
        if (r < 2 * I_AIN) { const int j = r / I_AIN; tr_item(a.in[9] + (size_t)j * 2048 * 4096, 2048, 4096, (bf16*)(ws + WS_AWIN) + (size_t)j * 4096 * 2048, 0, r - j * I_AIN, scr, lane); continue; } r -= 2 * I_AIN;
        if (r < 2 * I_SQ) { const int j = r / I_SQ; tr_item(a.in[13] + (size_t)j * 2048 * 2048, 2048, 2048, (bf16*)(ws + WS_AWOUT) + (size_t)j * 2048 * 2048, 0, r - j * I_SQ, scr, lane); continue; } r -= 2 * I_SQ;
        if (r < I_QKV) { tr_item(a.in[14], 2048, 6144, (bf16*)(ws + WS_BQKV), 0, r, scr, lane); continue; } r -= I_QKV;
        if (r < I_SQ) { tr_item(a.in[18], 2048, 2048, (bf16*)(ws + WS_BWO), 0, r, scr, lane); continue; } r -= I_SQ;
        if (r < I_SQ) { tr_item(a.in[19], 2048, 2048, (bf16*)(ws + WS_CWIN), 0, r, scr, lane); continue; } r -= I_SQ;
        if (r < I_AIN) { tr_item(a.in[28], 2048, 4096, (bf16*)(ws + WS_CGLU), 2048, r, scr, lane); continue; } r -= I_AIN;
        if (r >= I_WS) { r -= I_WS; const v4f* s = (const v4f*)(a.in[2] + (size_t)r * 4096) + lane; v4f* d = (v4f*)((float*)(ws + WS_HC) + (size_t)r * 4096) + lane;
#pragma unroll
          for (int j = 0; j < 16; ++j) d[64 * j] = s[64 * j];
          continue; }
        { const float* s = a.in[11] + (size_t)r * 2048 + lane * 4; bf16* d = (bf16*)(ws + WS_AWS) + (size_t)r * 2048 + lane * 4;
#pragma unroll
          for (int j = 0; j < 8; ++j) { const v4f v = *(const v4f*)(s + 256 * j); v2u o; o.x = pk_bf16(v[0], v[1]); o.y = pk_bf16(v[2], v[3]); *(v2u*)(d + 256 * j) = o; } }
    }
}

__device__ __forceinline__ void norm_phase(const float* hlat, float* hctx, const float* slab, const float* gain, const float* modl, int s, bf16* xn, int M, int gw, int NGW, int lane) {
    OPAQUE_V(lane);
    for (int row = gw; row < M; row += NGW) {
        const bool isctx = row >= ML; const int cls = isctx ? 2 : (row >> 12);
        const v4f* xr = (const v4f*)(isctx ? hctx + (size_t)(row - ML) * D : hlat + (size_t)row * D) + lane;
        const v4f* sh = (const v4f*)(modl + cls * MODW + (3 * s) * D) + lane; const v4f* sc = sh + D / 4; const v4f* gn = (const v4f*)gain + lane;
        v4f v[8]; float ss = 0.f;
#pragma unroll
        for (int j = 0; j < 8; ++j) v[j] = xr[64 * j];
        if (isctx && slab) {
            for (int sl = 0; sl < KSPLIT; ++sl) { const v4f* pr = (const v4f*)(slab + ((size_t)sl * 512 + (row - ML)) * D) + lane;
#pragma unroll
                for (int j = 0; j < 8; ++j) v[j] += pr[64 * j]; }
            v4f* xw = (v4f*)(hctx + (size_t)(row - ML) * D) + lane;
#pragma unroll
            for (int j = 0; j < 8; ++j) xw[64 * j] = v[j];
        }
#pragma unroll
        for (int j = 0; j < 8; ++j) ss += (v[j][0] * v[j][0] + v[j][1] * v[j][1]) + (v[j][2] * v[j][2] + v[j][3] * v[j][3]);
        const float r = rsqrtf(wave_sum(ss) * (1.0f / D) + RMS_EPS);
        v2u* o = (v2u*)(xn + (size_t)row * D) + lane;
#pragma unroll
        for (int j = 0; j < 8; ++j) { const v4f y = v[j] * r * gn[64 * j] * (sc[64 * j] + 1.0f) + sh[64 * j]; v2u w; w.x = pk_bf16(y[0], y[1]); w.y = pk_bf16(y[2], y[3]); o[64 * j] = w; }
    }
}

__device__ __forceinline__ void spatial_phase(const bf16* uv, const float* vss, const bf16* wsb, const float* vgain, const float* bsg, bf16* su, int nchunk,
                                              LAS unsigned char* lds, int vcu, int G, int tid, int lane, int wave) {
    OPAQUE_V(tid); OPAQUE_V(lane);
    LAS float* rq = (LAS float*)lds;
    const int h = lane >> 5, r32 = lane & 31, cb = wave & 3, pb0 = (wave >> 2) * 2;
    for (int unit = vcu; unit < nchunk * 16; unit += G) {
        const int ch = unit >> 4, g = unit & 15, row0 = ch * 128;
        __syncthreads();
        if (tid < 128) rq[tid] = rsqrtf(vss[row0 + tid] * (1.0f / D) + RMS_EPS);
        __syncthreads();
        const bf16* vp = uv + (size_t)row0 * 4096 + 2048 + 128 * g + 32 * cb + r32;
        b8 Af[8];
#pragma unroll
        for (int s = 0; s < 8; ++s) { float x[8];
#pragma unroll
            for (int j = 0; j < 8; ++j) { const int q = 16 * s + 8 * h + j; x[j] = bf2f(vp[(size_t)q * 4096]) * rq[q]; }
            v4u w; w.x = pk_bf16_m(x[0], x[1]); w.y = pk_bf16_m(x[2], x[3]); w.z = pk_bf16_m(x[4], x[5]); w.w = pk_bf16_m(x[6], x[7]); Af[s] = __builtin_bit_cast(b8, w); }
        v16f acc[2];
#pragma unroll
        for (int pbi = 0; pbi < 2; ++pbi) {
#pragma unroll
            for (int i = 0; i < 16; ++i) acc[pbi][i] = 0.f;
            const bf16* wp = wsb + ((size_t)g * 128 + 32 * (pb0 + pbi) + r32) * 128 + 8 * h;
#pragma unroll
            for (int s = 0; s < 8; ++s) { const b8 Bf = *(const b8*)(wp + 16 * s); acc[pbi] = MFMA32(Af[s], Bf, acc[pbi]); } }
#pragma unroll
        for (int pbi = 0; pbi < 2; ++pbi) { const int p = 32 * (pb0 + pbi) + r32; const float bsp = bsg[g * 128 + p]; const size_t row = (size_t)(row0 + p);
#pragma unroll
            for (int i4 = 0; i4 < 4; ++i4) { const int cc = 128 * g + 32 * cb + 8 * i4 + 4 * h; const v4f vg = *(const v4f*)(vgain + cc);
                const v2u uu = *(const v2u*)(uv + row * 4096 + cc);
                const float u0 = __uint_as_float(uu.x << 16), u1 = __uint_as_float(uu.x & 0xffff0000u), u2 = __uint_as_float(uu.y << 16), u3 = __uint_as_float(uu.y & 0xffff0000u);
                v2u w; w.x = pk_bf16(u0 * (acc[pbi][4 * i4 + 0] * vg[0] + bsp), u1 * (acc[pbi][4 * i4 + 1] * vg[1] + bsp)); w.y = pk_bf16(u2 * (acc[pbi][4 * i4 + 2] * vg[2] + bsp), u3 * (acc[pbi][4 * i4 + 3] * vg[3] + bsp));
                *(v2u*)(su + row * D + cc) = w; } }
    }
}

__device__ __forceinline__ void attn_phase(const bf16* qkv, const float* qkss, const float* qgain, const float* kgain, const float* rpb, bf16* o, int gw, int NGW, int lane) {
    OPAQUE_V(lane);
    const int h = lane >> 5, r32 = lane & 31;
    constexpr int NU_LAT = 2 * 16 * 64 * 2, NU_CTX = 2 * 16 * 8;
    for (int wu = gw; wu < NU_LAT + NU_CTX; wu += NGW) {
        const bool lat = wu < NU_LAT;
        int b, hd, qrow, r = 0, qh = 0, rstart = 0;
        if (lat) { qh = wu & 1; r = (wu >> 1) & 63; hd = (wu >> 7) & 15; b = wu >> 11; qrow = b * 4096 + r * 64 + 32 * qh + r32; rstart = r - 4 < 0 ? 0 : (r - 4 > 56 ? 56 : r - 4); }
        else { const int w = wu - NU_LAT; hd = (w >> 3) & 15; b = w >> 7; qrow = ML + b * 256 + 32 * (w & 7) + r32; }
        const float rqv = rsqrtf(qkss[(size_t)hd * MT + qrow] * (1.0f / 128.0f) + RMS_EPS) * 0.08838834764831845f;
        const bf16* qp = qkv + (size_t)qrow * 6144 + 128 * hd + 8 * h;
        b8 Qf[8];
#pragma unroll
        for (int s = 0; s < 8; ++s) { const v4u raw = *(const v4u*)(qp + 16 * s); const int d0 = 16 * s + 8 * h;
            const v4f g0 = *(const v4f*)(qgain + d0), g1 = *(const v4f*)(qgain + d0 + 4), k0 = *(const v4f*)(kgain + d0), k1 = *(const v4f*)(kgain + d0 + 4);
            v4u w;
            w.x = pk_bf16_m(__uint_as_float(raw.x << 16) * rqv * g0[0] * k0[0], __uint_as_float(raw.x & 0xffff0000u) * rqv * g0[1] * k0[1]);
            w.y = pk_bf16_m(__uint_as_float(raw.y << 16) * rqv * g0[2] * k0[2], __uint_as_float(raw.y & 0xffff0000u) * rqv * g0[3] * k0[3]);
            w.z = pk_bf16_m(__uint_as_float(raw.z << 16) * rqv * g1[0] * k1[0], __uint_as_float(raw.z & 0xffff0000u) * rqv * g1[1] * k1[1]);
            w.w = pk_bf16_m(__uint_as_float(raw.w << 16) * rqv * g1[2] * k1[2], __uint_as_float(raw.w & 0xffff0000u) * rqv * g1[3] * k1[3]);
            Qf[s] = __builtin_bit_cast(b8, w); }
        v16f Oacc[4];
#pragma unroll
        for (int db = 0; db < 4; ++db)
#pragma unroll
            for (int i = 0; i < 16; ++i) Oacc[db][i] = 0.f;
        float lsum = 0.f;
        const int ntile = lat ? 24 : 8, qc = 32 * qh + r32, cstart = qc - 8 < 0 ? 0 : (qc - 8 > 48 ? 48 : qc - 8);
        for (int kt = 0; kt < ntile; ++kt) {
            const bool win = lat && kt < 16;
            const int krow0 = win ? b * 4096 + 64 * rstart + 32 * kt : ML + b * 256 + 32 * (lat ? kt - 16 : kt);
            const bf16* kp = qkv + (size_t)(krow0 + r32) * 6144 + 2048 + 128 * hd + 8 * h;
            v16f sacc;
#pragma unroll
            for (int i = 0; i < 16; ++i) sacc[i] = 0.f;
#pragma unroll
            for (int s = 0; s < 8; ++s) { const b8 Kf = *(const b8*)(kp + 16 * s); sacc = MFMA32(Kf, Qf[s], sacc); }
            const float* rkp = qkss + (size_t)(16 + hd) * MT + krow0 + 4 * h;
            const float* bp = rpb + (size_t)(hd * 15 + (rstart + (kt >> 1) - r + 7)) * 31 + 15 - qc + 32 * (kt & 1);
            float p[16];
#pragma unroll
            for (int i4 = 0; i4 < 4; ++i4) { const v4f rk = *(const v4f*)(rkp + 8 * i4);
#pragma unroll
                for (int j = 0; j < 4; ++j) { const int key = 8 * i4 + 4 * h + j; const float sc = sacc[4 * i4 + j] * rsqrtf(rk[j] * (1.0f / 128.0f) + RMS_EPS);
                    float pv;
                    if (win) { const int kc = 32 * (kt & 1) + key; const bool valid = (unsigned)(kc - cstart) < 16u; const float bias = valid ? bp[key] : 0.f; pv = valid ? __expf(sc + bias) : 0.f; }
                    else pv = __expf(sc);
                    p[4 * i4 + j] = pv; lsum += pv; } }
            const bf16* vp = qkv + (size_t)krow0 * 6144 + 4096 + 128 * hd + r32;
#pragma unroll
            for (int s2 = 0; s2 < 2; ++s2) {
                v4u pw; pw.x = pk_bf16_m(p[8 * s2 + 0], p[8 * s2 + 1]); pw.y = pk_bf16_m(p[8 * s2 + 2], p[8 * s2 + 3]); pw.z = pk_bf16_m(p[8 * s2 + 4], p[8 * s2 + 5]); pw.w = pk_bf16_m(p[8 * s2 + 6], p[8 * s2 + 7]);
                const b8 Pf = __builtin_bit_cast(b8, pw);
#pragma unroll
                for (int db = 0; db < 4; ++db) { b8 Vf;
#pragma unroll
                    for (int j = 0; j < 8; ++j) { const int key = 16 * s2 + 8 * (j >> 2) + 4 * h + (j & 3); Vf[j] = (short)vp[(size_t)key * 6144 + 32 * db]; }
                    Oacc[db] = MFMA32(Vf, Pf, Oacc[db]); } }
        }
        lsum += __shfl_xor(lsum, 32);
        const float inv = 1.0f / lsum;
        bf16* op = o + (size_t)qrow * D + 128 * hd + 4 * h;
#pragma unroll
        for (int db = 0; db < 4; ++db)
#pragma unroll
            for (int i4 = 0; i4 < 4; ++i4) { v2u w; w.x = pk_bf16(Oacc[db][4 * i4 + 0] * inv, Oacc[db][4 * i4 + 1] * inv); w.y = pk_bf16(Oacc[db][4 * i4 + 2] * inv, Oacc[db][4 * i4 + 3] * inv);
                *(v2u*)(op + 32 * db + 8 * i4) = w; }
    }
}

__device__ __forceinline__ void scan_phase(const bf16* ub, const float* a_re, const float* a_im, const float* log_dt, const float* b_re, const float* b_im, const float* c_re, const float* c_im,
                                           float* ybuf, LAS unsigned char* lds, int blk, int G, int wave, int lane) {
    OPAQUE_V(lane);
    if (wave >= 2) return;
    LAS float* BU = (LAS float*)(lds + wave * 32768);
    LAS unsigned char* HS = lds + wave * 32768 + 16384;
    LAS unsigned short* BB = (LAS unsigned short*)(lds + wave * 32768 + 16384 + 8704);
    const int h = lane >> 5, r32 = lane & 31, p = lane, ch = lane & 15, l4 = lane >> 4;
    for (int chain = blk * 2 + wave; chain < 512; chain += 2 * G) {
        const int dir = chain & 1, g = (chain >> 1) & 127, b = chain >> 8, dg = dir * 128 + g;
        const float lr = a_re[(size_t)dg * 64 + p], li = a_im[(size_t)dg * 64 + p], dt = expf(log_dt[dg]);
        const float er = expf(lr * dt), ar = er * cosf(li * dt), ai = er * sinf(li * dt);
        { const float nr = ar - 1.0f, ni = ai, den = 1.0f / (lr * lr + li * li), cr = (nr * lr + ni * li) * den, ci = (ni * lr - nr * li) * den;
          const float* brp = b_re + ((size_t)dg * 64 + p) * 16; const float* bip = b_im + ((size_t)dg * 64 + p) * 16;
#pragma unroll
          for (int c4 = 0; c4 < 4; ++c4) { const v4f br = *(const v4f*)(brp + 4 * c4), bi = *(const v4f*)(bip + 4 * c4);
              v2u wr_, wi_; wr_.x = pk_bf16(cr * br[0] - ci * bi[0], cr * br[1] - ci * bi[1]); wr_.y = pk_bf16(cr * br[2] - ci * bi[2], cr * br[3] - ci * bi[3]);
              wi_.x = pk_bf16(cr * bi[0] + ci * br[0], cr * bi[1] + ci * br[1]); wi_.y = pk_bf16(cr * bi[2] + ci * br[2], cr * bi[3] + ci * br[3]);
              *(LAS v2u*)(BB + (p * 2 + 0) * 16 + 4 * c4) = wr_; *(LAS v2u*)(BB + (p * 2 + 1) * 16 + 4 * c4) = wi_; } }
        LDS_WAIT(); asm volatile("" ::: "memory");
        b8 Bf[4];
#pragma unroll
        for (int cb = 0; cb < 4; ++cb) Bf[cb] = *(const LAS b8*)(BB + ((16 * cb + (r32 >> 1)) * 2 + (r32 & 1)) * 16 + 8 * h);
        b8 Cf[4];
#pragma unroll
        for (int ks = 0; ks < 4; ++ks) { const v4f cre = *(const v4f*)(c_re + ((size_t)dg * 16 + ch) * 64 + 16 * ks + 4 * l4), cim = *(const v4f*)(c_im + ((size_t)dg * 16 + ch) * 64 + 16 * ks + 4 * l4);
            v4u w; w.x = pk_bf16_m(cre[0], -cim[0]); w.y = pk_bf16_m(cre[1], -cim[1]); w.z = pk_bf16_m(cre[2], -cim[2]); w.w = pk_bf16_m(cre[3], -cim[3]); Cf[ks] = __builtin_bit_cast(b8, w); }
        float hr = 0.f, hi = 0.f;
        for (int bi_ = 0; bi_ < 136; ++bi_) {
            int rb, sg;
            if (dir == 0) { rb = bi_ < 8 ? ML + b * 256 + 32 * bi_ : b * 4096 + 32 * (bi_ - 8); sg = 1; }
            else { rb = bi_ < 8 ? ML + b * 256 + 255 - 32 * bi_ : b * 4096 + 4095 - 32 * (bi_ - 8); sg = -1; }
            const b8 Uf = *(const b8*)(ub + (size_t)(rb + sg * r32) * D + 16 * g + 8 * h);
#pragma unroll
            for (int cb = 0; cb < 4; ++cb) { v16f z;
#pragma unroll
                for (int i = 0; i < 16; ++i) z[i] = 0.f;
                const v16f dacc = MFMA32(Uf, Bf[cb], z);
#pragma unroll
                for (int i = 0; i < 16; ++i) BU[((i & 3) + 8 * (i >> 2) + 4 * h) * 128 + 32 * cb + r32] = dacc[i]; }
            LDS_WAIT(); asm volatile("" ::: "memory");
            v2f bu[32];
#pragma unroll
            for (int i = 0; i < 32; ++i) bu[i] = *(const LAS v2f*)(BU + i * 128 + 2 * p);
#pragma unroll
            for (int i = 0; i < 32; ++i) { const float nr = ar * hr - ai * hi + bu[i][0], ni = ar * hi + ai * hr + bu[i][1]; hr = nr; hi = ni;
                *(LAS unsigned*)(HS + i * 272 + 4 * p) = pk_bf16(hr, hi); }
            LDS_WAIT(); asm volatile("" ::: "memory");
#pragma unroll
            for (int tb = 0; tb < 2; ++tb) { v4f ya = {0.f, 0.f, 0.f, 0.f};
#pragma unroll
                for (int ks = 0; ks < 4; ++ks) { const b8 Hf = *(const LAS b8*)(HS + (16 * tb + ch) * 272 + (32 * ks + 8 * l4) * 2); ya = MFMA16(Cf[ks], Hf, ya); }
                const int row = rb + sg * (16 * tb + ch);
                *(v4f*)(ybuf + ((size_t)dir * MT + row) * D + 16 * g + 4 * l4) = ya; }
        }
    }
}
__device__ __forceinline__ void s5post_phase(const bf16* ub, const float* ybuf, const float* cd, bf16* xg, int M, int gw, int NGW, int lane) {
    OPAQUE_V(lane);
    for (int row = gw; row < M; row += NGW) {
        const v2u* up = (const v2u*)(ub + (size_t)row * D) + lane; const v4f* yf = (const v4f*)(ybuf + (size_t)row * D) + lane; const v4f* yr = (const v4f*)(ybuf + ((size_t)MT + row) * D) + lane;
        const v4f* dp = (const v4f*)cd + lane; v2u* o = (v2u*)(xg + (size_t)row * D) + lane;
#pragma unroll
        for (int j = 0; j < 8; ++j) { const v2u uu = up[64 * j]; const v4f d = dp[64 * j], a = yf[64 * j], c = yr[64 * j];
            const float y0 = d[0] * __uint_as_float(uu.x << 16) + a[0] + c[0], y1 = d[1] * __uint_as_float(uu.x & 0xffff0000u) + a[1] + c[1];
            const float y2 = d[2] * __uint_as_float(uu.y << 16) + a[2] + c[2], y3 = d[3] * __uint_as_float(uu.y & 0xffff0000u) + a[3] + c[3];
            v2u w; w.x = pk_bf16(pg8::fgelu(y0), pg8::fgelu(y1)); w.y = pk_bf16(pg8::fgelu(y2), pg8::fgelu(y3)); o[64 * j] = w; }
    }
}

__global__ void __launch_bounds__(NTHR, 2) fwd_kernel(Args a) {
    extern __shared__ __attribute__((aligned(16))) unsigned char lds_raw[];
    LAS unsigned char* lds = (LAS unsigned char*)lds_raw;
    volatile LAS unsigned* MISC = (volatile LAS unsigned*)(lds + MISC_OFF);
    const int tid = threadIdx.x, lane = tid & 63, wave = __builtin_amdgcn_readfirstlane(tid >> 6);
    const int G = gridDim.x, bx = blockIdx.x, vcu = (G % 8 == 0) ? (bx % 8) * (G / 8) + bx / 8 : bx;
    const int gw = vcu * NWAVES + wave, NGW = G * NWAVES;
    for (int u = tid; u < (LDS_BYTES - 131072) / 4; u += NTHR) ((LAS unsigned*)(lds + 131072))[u] = 0u;
    __syncthreads();
    unsigned char* ws = a.ws;
    XcdBarrier bar = xcd_barrier_post((unsigned*)(ws + WS_CTL) + CW_BAR + a.li * BAR_STRIDE, MISC + 8);
    const int lo = a.ph_lo, hi = a.ph_hi;
    int pc = 0;
#define PH_IN (lo <= pc && pc < hi)
#define PH_END() do { if (pc + 1 < hi) xcd_barrier(bar); } while (0)
    float* mod = (float*)(ws + WS_MOD); float* hc = (float*)(ws + WS_HC);
    bf16* xn = (bf16*)(ws + WS_XN); bf16* act = (bf16*)(ws + WS_ACT); float* ybuf = (float*)(ws + WS_Y);
    float* vss = (float*)(ws + WS_VSS); float* qkss = (float*)(ws + WS_QKSS); float* slab = (float*)(ws + WS_SLAB);
    bool pend = false;

    if (PH_IN) { if (!NO_P0) p0_prologue(a, lds, gw, NGW, tid, lane, wave); PH_END(); } ++pc;

    for (int f = 0; f < 8; ++f) {
        const int layer = f >> 1, sub = f & 1, kind = layer % 3, M = (layer == 3) ? ML : MT;
        const float* modl = mod + (size_t)layer * 3 * MODW;
        const float* hin_l = (f == 0) ? a.in[0] : (const float*)a.out;
        if (PH_IN) { norm_phase(hin_l, hc, pend ? slab : nullptr, a.in[6] + (size_t)(layer * 3 + 2 * sub) * D, modl, 2 * sub, xn, M, gw, NGW, lane); PH_END(); } ++pc; pend = false;
        if (PH_IN) { pg8::Gemm g{xn, (const bf16*)(ws + WS_WGU) + (size_t)f * 11264 * 2048, M, 11264, 2048}; pg8::StaticOrder S; S.init(M, 11264, 2048, G, bx);
            pg8::EpiSwiglu E{act, DFF}; pg8::gemm_phase<pg8::EpiSwiglu, pg8::StaticOrder, true, true>(lds, g, S, E); PH_END(); } ++pc;
        if (PH_IN) { pg8::Gemm g{act, (const bf16*)(ws + WS_WDN) + (size_t)f * 2048 * 5632, M, 2048, DFF}; pg8::SplitOrder S; S.init(2048, DFF, G, bx, KSPLIT, M > ML);
            pg8::EpiRes E{hin_l, hc, a.out, hc, modl + (6 * sub + 2) * D, slab, 0.5f}; pg8::gemm_phase<pg8::EpiRes, pg8::SplitOrder, true, true>(lds, g, S, E); PH_END(); } ++pc; pend = M > ML;
        if (sub == 0) {
            const int j = layer / 3;
            if (PH_IN) { norm_phase(a.out, hc, pend ? slab : nullptr, a.in[6] + (size_t)(layer * 3 + 1) * D, modl, 1, xn, M, gw, NGW, lane); PH_END(); } ++pc; pend = false;
            if (kind == 0) {
                if (PH_IN) { pg8::Gemm g{xn, (const bf16*)(ws + WS_AWIN) + (size_t)j * 4096 * 2048, M, 4096, 2048}; pg8::StaticOrder S; S.init(M, 4096, 2048, G, bx);
                    pg8::EpiBf<1> E{act, 4096, vss + (size_t)j * MT}; pg8::gemm_phase<pg8::EpiBf<1>, pg8::StaticOrder, true, true>(lds, g, S, E); PH_END(); } ++pc;
                if (PH_IN) { if (!NO_SPAT) spatial_phase(act, vss + (size_t)j * MT, (const bf16*)(ws + WS_AWS) + (size_t)j * 16 * 128 * 128, a.in[10] + (size_t)j * D, a.in[12] + (size_t)j * 16 * 128, xn, M / 128, lds, vcu, G, tid, lane, wave); PH_END(); } ++pc;
            } else if (kind == 1) {
                if (PH_IN) { pg8::Gemm g{xn, (const bf16*)(ws + WS_BQKV), M, 6144, 2048}; pg8::StaticOrder S; S.init(M, 6144, 2048, G, bx);
                    pg8::EpiBf<2> E{act, 6144, qkss}; pg8::gemm_phase<pg8::EpiBf<2>, pg8::StaticOrder, true, true>(lds, g, S, E); PH_END(); } ++pc;
                if (PH_IN) { if (!NO_ATTN) attn_phase(act, qkss, a.in[15], a.in[16], a.in[17], xn, gw, NGW, lane); PH_END(); } ++pc;
            } else {
                if (PH_IN) { pg8::Gemm g{xn, (const bf16*)(ws + WS_CWIN), M, 2048, 2048}; pg8::StaticOrder S; S.init(M, 2048, 2048, G, bx);
                    pg8::EpiBf<0> E{act, 2048, nullptr}; pg8::gemm_phase<pg8::EpiBf<0>, pg8::StaticOrder, true, true>(lds, g, S, E); PH_END(); } ++pc;
                if (PH_IN) { if (!NO_SCAN) scan_phase(act, a.in[20], a.in[21], a.in[22], a.in[23], a.in[24], a.in[25], a.in[26], ybuf, lds, bx, G, wave, lane); PH_END(); } ++pc;
                if (PH_IN) { s5post_phase(act, ybuf, a.in[27], xn, M, gw, NGW, lane); PH_END(); } ++pc;
            }
            if (kind != 2) {
                if (PH_IN) { const bf16* wo = kind == 0 ? (const bf16*)(ws + WS_AWOUT) + (size_t)j * 2048 * 2048 : (const bf16*)(ws + WS_BWO);
                    pg8::Gemm g{xn, wo, M, 2048, 2048}; pg8::SplitOrder S; S.init(2048, 2048, G, bx, KSPLIT, M > ML);
                    pg8::EpiRes E{a.out, hc, a.out, hc, modl + 5 * D, slab, 1.0f}; pg8::gemm_phase<pg8::EpiRes, pg8::SplitOrder, true, true>(lds, g, S, E); PH_END(); } ++pc; pend = M > ML;
            } else {
                if (PH_IN) { pg8::Gemm g{xn, (const bf16*)(ws + WS_CGLU), M, 4096, 2048}; pg8::StaticOrder S; S.init(M, 4096, 2048, G, bx);
                    pg8::EpiGluRes E{a.out, hc, a.out, hc, modl + 5 * D}; pg8::gemm_phase<pg8::EpiGluRes, pg8::StaticOrder, true, true>(lds, g, S, E); PH_END(); } ++pc;
            }
        }
    }
#undef PH_IN
#undef PH_END
}

extern "C" void kernel_launch(void* const* d_in, const int* in_sizes, int n_in, void* d_out, int out_size, void* d_ws, size_t ws_size, hipStream_t stream) {
    static int grid = 0;
    if (grid == 0) {
        if (n_in != 29 || out_size != ML * D || ws_size < WS_END) { fprintf(stderr, "kernel_launch: unexpected shapes (n_in %d out %d ws %zu)\n", n_in, out_size, ws_size); grid = -1; return; }
        int dev = 0, cus = 0, per_cu = 0;
        if (hipGetDevice(&dev) != hipSuccess || hipDeviceGetAttribute(&cus, hipDeviceAttributeMultiprocessorCount, dev) != hipSuccess) { grid = -1; return; }
        if (hipFuncSetAttribute((const void*)fwd_kernel, hipFuncAttributeMaxDynamicSharedMemorySize, LDS_BYTES) != hipSuccess) { fprintf(stderr, "kernel_launch: hipFuncSetAttribute failed\n"); grid = -1; return; }
        if (hipOccupancyMaxActiveBlocksPerMultiprocessor(&per_cu, (const void*)fwd_kernel, NTHR, LDS_BYTES) != hipSuccess || per_cu < 1) fprintf(stderr, "kernel_launch: occupancy query says %d blocks per CU\n", per_cu);
        (void)hipGetLastError();
        grid = cus;
    }
    if (grid < 0) return;
    if (hipMemsetAsync(d_ws, 0, ZERO_BYTES, stream) != hipSuccess) { fprintf(stderr, "kernel_launch: memset failed\n"); return; }
    Args a{};
    for (int i = 0; i < 29; ++i) a.in[i] = (const float*)d_in[i];
    a.out = (float*)d_out; a.ws = (unsigned char*)d_ws; a.pad = 0;
#if MK_ONE_LAUNCH
    a.ph_lo = 0; a.ph_hi = NPHASES; a.li = 0;
    hipLaunchKernelGGL(fwd_kernel, dim3(grid), dim3(NTHR), LDS_BYTES, stream, a);
#else
    for (int k = 0; k < NPHASES; ++k) { a.ph_lo = k; a.ph_hi = k + 1; a.li = k;
        hipLaunchKernelGGL(fwd_kernel, dim3(grid), dim3(NTHR), LDS_BYTES, stream, a); }
#endif
    const hipError_t le = hipPeekAtLastError();
    if (le != hipSuccess) fprintf(stderr, "kernel_launch: launch failed: %s\n", hipGetErrorName(le));
}
```

```cpp
#include <hip/hip_runtime.h>
#include <cstdio>
#include <cstdint>
namespace pg8 {
#define PG8_LAS __attribute__((address_space(3)))
typedef unsigned short bf16_t;
typedef short bf16x8 __attribute__((ext_vector_type(8)));
typedef float f32x4 __attribute__((ext_vector_type(4)));
typedef unsigned u32x4 __attribute__((ext_vector_type(4)));
constexpr int BM = 256, BK = 64, HALF = 128, HTB = HALF * BK * 2  , STAGE_BYTES = 8 * HTB, NXCD = 8, WGM = 8;

__host__ __device__ __forceinline__ int lds_byte(int r, int c) { const int st = (r >> 4) * 2 + (c >> 5), rr = r & 15, cc = c & 31, ob = rr * 64 + cc * 2; return st * 1024 + (ob ^ (((ob >> 9) & 1) << 5)); }
__host__ __device__ __forceinline__ void stage_rc(int b, int& R, int& C) { const int st = b / 1024, sb = b % 1024, swz = sb ^ (((sb >> 9) & 1) << 5); R = (st >> 1) * 16 + swz / 64; C = (st & 1) * 32 + (swz % 64) / 2; }
__host__ __device__ __forceinline__ int perm32(int rho) { const int n = rho >> 4, i = rho & 15; return 8 * (i >> 2) + 4 * n + (i & 3); }

struct Unit { int pm, pn, kt0, nkt, part; };
struct Gemm { const bf16_t* A; const bf16_t* Bt; int M, N, K; };

struct StaticOrder {
    int nM, nN, nwg, G, c, nkt;
    __host__ __device__ void init(int M, int N, int K, int G_, int c_) { nM = M / BM; nN = N / BM; nwg = nM * nN; G = G_; c = c_; nkt = K / BK; }
    __host__ __device__ bool next(int i, Unit& u) const {
        const long L = (long)i * G + c; if (L >= nwg) return false;
        int wgid = (int)L; { const int q = nwg / NXCD, r = nwg % NXCD, xcd = wgid % NXCD, off = wgid / NXCD; wgid = (xcd < r ? xcd * (q + 1) : r * (q + 1) + (xcd - r) * q) + off; }
        const int nig = WGM * nN, gid = wgid / nig, fm = gid * WGM, gsz = (nM - fm) < WGM ? (nM - fm) : WGM;
        u.pm = fm + ((wgid % nig) % gsz); u.pn = (wgid % nig) / gsz; u.kt0 = 0; u.nkt = nkt; u.part = 0; return true;
    }
    __device__ __forceinline__ void a_ready(const Unit&) const {}
    __device__ __forceinline__ void done(const Unit&) const {}
};
struct SplitOrder {
    StaticOrder lat; int nlat, npiece, nN, nkt, split, G, c;
    __device__ void init(int N, int K, int G_, int c_, int split_, bool has_ctx) { lat.init(8192, N, K, G_, c_); nN = N / BM; nkt = K / BK; split = split_; nlat = 32 * nN; npiece = has_ctx ? 2 * nN * split_ : 0; G = G_; c = c_; }
    __device__ bool next(int i, Unit& u) const {
        const long L = (long)i * G + c;
        if (L < nlat) return lat.next(i, u);
        const int q = (int)(L - nlat); if (q >= npiece) return false;
        const int cu = q / split, s = q - cu * split, PP = nkt >> 1, p0 = s * PP / split, p1 = (s + 1) * PP / split;
        u.pm = 32 + cu / nN; u.pn = cu % nN; u.kt0 = 2 * p0; u.nkt = 2 * (p1 - p0); u.part = 1 + s; return true;
    }
    __device__ __forceinline__ void a_ready(const Unit&) const {}
    __device__ __forceinline__ void done(const Unit&) const {}
};
__device__ __forceinline__ unsigned cvt_pk_bf16(float lo, float hi) { unsigned r; asm volatile("v_cvt_pk_bf16_f32 %0, %1, %2" : "=v"(r) : "v"(lo), "v"(hi)); return r; }
__device__ __forceinline__ float fsigmoid(float x) { return __builtin_amdgcn_rcpf(1.0f + __builtin_amdgcn_exp2f(-1.44269504f * x)); }
__device__ __forceinline__ float fsilu(float x) { return x * fsigmoid(x); }
__device__ __forceinline__ float fgelu(float x) { return x * fsigmoid(1.5957691216f * (x + 0.044715f * x * x * x)); }
constexpr int ROWS_LAT = 8192, ROWS_ALL = 8704, MODW = 9 * 2048;

struct EpiSwiglu {
    static constexpr bool PERM = true, AFTER_DRAIN = false;
    bf16_t* O; int ldc;
    __device__ __forceinline__ void operator()(const f32x4 (&acc)[2][2][4][2], const Unit& u, int wr, int wc, int fr, int fq) const {
        const int row0 = u.pm * BM + wr * 64 + fr, col0 = u.pn * HALF + wc * 32 + 8 * fq;
#pragma unroll
        for (int ai = 0; ai < 2; ++ai)
#pragma unroll
            for (int m = 0; m < 4; ++m) { bf16_t* rowp = O + (size_t)(row0 + ai * HALF + m * 16) * ldc + col0;
                const f32x4 g0 = acc[ai][0][m][0], g1 = acc[ai][0][m][1], u0 = acc[ai][1][m][0], u1 = acc[ai][1][m][1];
                u32x4 w; w.x = cvt_pk_bf16(fsilu(g0[0]) * u0[0], fsilu(g0[1]) * u0[1]); w.y = cvt_pk_bf16(fsilu(g0[2]) * u0[2], fsilu(g0[3]) * u0[3]);
                w.z = cvt_pk_bf16(fsilu(g1[0]) * u1[0], fsilu(g1[1]) * u1[1]); w.w = cvt_pk_bf16(fsilu(g1[2]) * u1[2], fsilu(g1[3]) * u1[3]);
                *(u32x4*)rowp = w; }
    }
};
struct EpiRes {
    static constexpr bool PERM = false, AFTER_DRAIN = false;
    const float* blat; const float* bctx; float* olat; float* octx; const float* gate; float* slab; float f;
    __device__ __forceinline__ void operator()(const f32x4 (&acc)[2][2][4][2], const Unit& u, int wr, int wc, int fr, int fq) const {
        const bool isctx = u.pm >= 32; const int cls = isctx ? 2 : (u.pm >> 4);
        const float* base = isctx ? bctx : blat; float* out = isctx ? octx : olat;
        const int row0 = (isctx ? u.pm - 32 : u.pm) * BM + wr * 64 + fr, col0 = u.pn * BM + wc * 32 + 4 * fq;
        const float* gp = gate + cls * MODW + col0;
        f32x4 gv[2][2];
#pragma unroll
        for (int bj = 0; bj < 2; ++bj)
#pragma unroll
            for (int n = 0; n < 2; ++n) gv[bj][n] = *(const f32x4*)(gp + bj * HALF + n * 16) * f;
#pragma unroll
        for (int ai = 0; ai < 2; ++ai)
#pragma unroll
            for (int m = 0; m < 4; ++m) { const size_t off = (size_t)(row0 + ai * HALF + m * 16) * 2048 + col0;
#pragma unroll
                for (int bj = 0; bj < 2; ++bj)
#pragma unroll
                    for (int n = 0; n < 2; ++n) {
                        if (u.part) *(f32x4*)(slab + (size_t)(u.part - 1) * (512 * 2048) + off + bj * HALF + n * 16) = gv[bj][n] * acc[ai][bj][m][n];
                        else { const f32x4 b = *(const f32x4*)(base + off + bj * HALF + n * 16); *(f32x4*)(out + off + bj * HALF + n * 16) = b + gv[bj][n] * acc[ai][bj][m][n]; } } }
    }
};
struct EpiGluRes {
    static constexpr bool PERM = false, AFTER_DRAIN = false;
    const float* blat; const float* bctx; float* olat; float* octx; const float* gate;
    __device__ __forceinline__ void operator()(const f32x4 (&acc)[2][2][4][2], const Unit& u, int wr, int wc, int fr, int fq) const {
        const bool isctx = u.pm >= 32; const int cls = isctx ? 2 : (u.pm >> 4);
        const float* base = isctx ? bctx : blat; float* out = isctx ? octx : olat;
        const int row0 = (isctx ? u.pm - 32 : u.pm) * BM + wr * 64 + fr, col0 = u.pn * HALF + wc * 32 + 4 * fq;
        const float* gp = gate + cls * MODW + col0;
        f32x4 gv[2];
#pragma unroll
        for (int n = 0; n < 2; ++n) gv[n] = *(const f32x4*)(gp + n * 16);
#pragma unroll
        for (int ai = 0; ai < 2; ++ai)
#pragma unroll
            for (int m = 0; m < 4; ++m) { const size_t off = (size_t)(row0 + ai * HALF + m * 16) * 2048 + col0;
#pragma unroll
                for (int n = 0; n < 2; ++n) { const f32x4 b = *(const f32x4*)(base + off + n * 16); const f32x4 av = acc[ai][0][m][n], gg = acc[ai][1][m][n];
                    f32x4 v; v[0] = av[0] * fsigmoid(gg[0]); v[1] = av[1] * fsigmoid(gg[1]); v[2] = av[2] * fsigmoid(gg[2]); v[3] = av[3] * fsigmoid(gg[3]);
                    *(f32x4*)(out + off + n * 16) = b + gv[n] * v; } }
    }
};
template <int MODE> struct EpiBf {
    static constexpr bool PERM = true, AFTER_DRAIN = false;
    bf16_t* O; int ldc; float* ss;
    __device__ __forceinline__ void operator()(const f32x4 (&acc)[2][2][4][2], const Unit& u, int wr, int wc, int fr, int fq) const {
        const int row0 = u.pm * BM + wr * 64 + fr, col0 = u.pn * BM + wc * 32 + 8 * fq;
#pragma unroll
        for (int ai = 0; ai < 2; ++ai)
#pragma unroll
            for (int m = 0; m < 4; ++m) { const int row = row0 + ai * HALF + m * 16; bf16_t* rowp = O + (size_t)row * ldc + col0; float s1 = 0.f;
#pragma unroll
                for (int bj = 0; bj < 2; ++bj) { f32x4 v0 = acc[ai][bj][m][0], v1 = acc[ai][bj][m][1];
                    if (MODE == 1) {
#pragma unroll
                        for (int j = 0; j < 4; ++j) { v0[j] = fgelu(v0[j]); v1[j] = fgelu(v1[j]); } }
                    u32x4 w; w.x = cvt_pk_bf16(v0[0], v0[1]); w.y = cvt_pk_bf16(v0[2], v0[3]); w.z = cvt_pk_bf16(v1[0], v1[1]); w.w = cvt_pk_bf16(v1[2], v1[3]);
                    *(u32x4*)(rowp + bj * HALF) = w;
                    if (MODE != 0) { float s = (v0[0] * v0[0] + v0[1] * v0[1]) + (v0[2] * v0[2] + v0[3] * v0[3]) + (v1[0] * v1[0] + v1[1] * v1[1]) + (v1[2] * v1[2] + v1[3] * v1[3]);
                        if (MODE == 2) { if (u.pn < 16) { s += __shfl_xor(s, 16); s += __shfl_xor(s, 32); if (fq == 0) unsafeAtomicAdd(ss + (size_t)(2 * u.pn + bj) * ROWS_ALL + row, s); } }
                        else s1 += s; } }
                if (MODE == 1) { if (u.pn >= 8) { s1 += __shfl_xor(s1, 16); s1 += __shfl_xor(s1, 32); if (fq == 0) unsafeAtomicAdd(ss + row, s1); } } }
    }
};

template <class Epi, class Sched, bool ALIGN_EPI = false, bool SP2 = false>
__device__ __forceinline__ void gemm_phase(PG8_LAS unsigned char* lds, const Gemm g, const Sched& S, const Epi& E) {
    int tid_l = threadIdx.x; asm volatile("" : "+v"(tid_l));
    const int tid = tid_l, wid = __builtin_amdgcn_readfirstlane(tid >> 6), lane = tid & 63, wr = wid >> 2, wc = wid & 3, fr = lane & 15, fq = lane >> 4;
    const int K = g.K;
    unsigned voffA[2], voffB[2];
#pragma unroll
    for (int i = 0; i < 2; ++i) { int R, C; stage_rc(tid * 16 + i * 8192, R, C); const int Rb = Epi::PERM ? ((R & ~31) + perm32(R & 31)) : R;
        voffA[i] = (unsigned)(R * K + C) * 2u; voffB[i] = (unsigned)(Rb * K + C) * 2u; }
    const size_t kstep = (size_t)(BK * 2);
    const size_t hstep = (size_t)HALF * K * 2;
    const size_t tstep = 2 * hstep;
    const unsigned ldsw = (unsigned)wid * 1024u;
    const int aoff = lds_byte(wr * 64 + fr, fq * 8), boff = lds_byte(wc * 32 + fr, fq * 8);
#define PG8_SA(b, h) (((b) * 2 + (h)) * HTB)
#define PG8_SB(b, h) ((4 + (b) * 2 + (h)) * HTB)
#define PG8_STAGE(bufoff, gbase, voff) do { _Pragma("unroll") for (int _i = 0; _i < 2; ++_i) \
        __builtin_amdgcn_global_load_lds((const unsigned*)((const char*)(gbase) + (voff)[_i]), (PG8_LAS unsigned*)(lds + (bufoff) + ldsw + _i * 8192), 16, 0, 0); } while (0)
#define PG8_LDA(dst, b, h) do { _Pragma("unroll") for (int m = 0; m < 4; ++m) _Pragma("unroll") for (int k = 0; k < 2; ++k) dst[m][k] = *(const PG8_LAS bf16x8*)(lds + PG8_SA(b, h) + aoff + m * 2048 + k * 1024); } while (0)
#define PG8_LDB(dst, b, h) do { _Pragma("unroll") for (int n = 0; n < 2; ++n) _Pragma("unroll") for (int k = 0; k < 2; ++k) dst[n][k] = *(const PG8_LAS bf16x8*)(lds + PG8_SB(b, h) + boff + n * 2048 + k * 1024); } while (0)
#define PG8_MMA(ai, bj, At, Bt) do { __builtin_amdgcn_s_setprio(1); _Pragma("unroll") for (int m = 0; m < 4; ++m) _Pragma("unroll") for (int n = 0; n < 2; ++n) _Pragma("unroll") for (int k = 0; k < 2; ++k) \
        acc[ai][bj][m][n] = __builtin_amdgcn_mfma_f32_16x16x32_bf16(Bt[n][k], At[m][k], acc[ai][bj][m][n], 0, 0, 0); __builtin_amdgcn_s_setprio(0); } while (0)
#define PG8_WAIT_V(n) asm volatile("s_waitcnt vmcnt(" #n ")" ::: "memory")
#define PG8_WAIT_L(n) asm volatile("s_waitcnt lgkmcnt(" #n ")" ::: "memory")
#define PG8_BAR __builtin_amdgcn_s_barrier()
#define PG8_SCHED __builtin_amdgcn_sched_barrier(0)
    Unit cur, nxt; int ui = 0;
    if (!S.next(0, cur)) return;
    f32x4 acc[2][2][4][2];
#pragma unroll
    for (int a = 0; a < 2; ++a)
#pragma unroll
        for (int b = 0; b < 2; ++b)
#pragma unroll
            for (int m = 0; m < 4; ++m)
#pragma unroll
                for (int n = 0; n < 2; ++n) acc[a][b][m][n] = (f32x4){0.f, 0.f, 0.f, 0.f};
    bf16x8 At[4][2], B0[2][2], B1[2][2];
    const char* cA = (const char*)g.A + (size_t)cur.pm * tstep + (size_t)cur.kt0 * kstep; const char* cB = (const char*)g.Bt + (size_t)cur.pn * tstep + (size_t)cur.kt0 * kstep;
    S.a_ready(cur);
    if constexpr (SP2) {
        PG8_STAGE(PG8_SB(0, 0), cB, voffB); PG8_STAGE(PG8_SB(0, 1), cB + hstep, voffB); PG8_STAGE(PG8_SA(0, 0), cA, voffA); PG8_STAGE(PG8_SA(0, 1), cA + hstep, voffA);
        if (wr == 1) PG8_BAR;
        PG8_WAIT_V(2); PG8_BAR;
        PG8_STAGE(PG8_SB(1, 0), cB + kstep, voffB); PG8_STAGE(PG8_SA(1, 0), cA + kstep, voffA); PG8_STAGE(PG8_SB(1, 1), cB + hstep + kstep, voffB);
        PG8_WAIT_V(6); PG8_BAR;
    } else {
        PG8_STAGE(PG8_SB(0, 0), cB, voffB); PG8_STAGE(PG8_SA(0, 0), cA, voffA); PG8_STAGE(PG8_SB(0, 1), cB + hstep, voffB); PG8_STAGE(PG8_SA(0, 1), cA + hstep, voffA);
        if (wr == 1) PG8_BAR;
        PG8_WAIT_V(4); PG8_BAR;
        PG8_STAGE(PG8_SB(1, 0), cB + kstep, voffB); PG8_STAGE(PG8_SA(1, 0), cA + kstep, voffA); PG8_STAGE(PG8_SB(1, 1), cB + hstep + kstep, voffB);
        PG8_WAIT_V(6); PG8_BAR;
    }
    for (;;) {
        const bool has_next = S.next(ui + 1, nxt);
        const char* nA = has_next ? (const char*)g.A + (size_t)nxt.pm * tstep + (size_t)nxt.kt0 * kstep : cA; const char* nB = has_next ? (const char*)g.Bt + (size_t)nxt.pn * tstep + (size_t)nxt.kt0 * kstep : cB;
        const int nt = cur.nkt;
        for (int t = 0; t < nt; t += 2) {
            const bool last = (t == nt - 2);
            const char* a1 = cA + (size_t)(t + 1) * kstep;
            const char* a2 = last ? nA : cA + (size_t)(t + 2) * kstep; const char* b2 = last ? nB : cB + (size_t)(t + 2) * kstep;
            const char* a3 = a2 + kstep; const char* b3 = b2 + kstep;
            if (last && has_next) S.a_ready(nxt);
            if constexpr (SP2) {
            PG8_LDB(B0, 0, 0); PG8_LDB(B1, 0, 1); PG8_SCHED; PG8_LDA(At, 0, 0); PG8_STAGE(PG8_SA(1, 1), a1 + hstep, voffA);
            PG8_WAIT_V(8); PG8_WAIT_L(0); PG8_BAR; PG8_MMA(0, 0, At, B0); PG8_MMA(0, 1, At, B1); PG8_BAR; PG8_SCHED;
            PG8_LDA(At, 0, 1); PG8_STAGE(PG8_SB(0, 0), b2, voffB); PG8_STAGE(PG8_SB(0, 1), b2 + hstep, voffB); PG8_STAGE(PG8_SA(0, 0), a2, voffA);
            PG8_WAIT_V(8); PG8_WAIT_L(0); PG8_BAR; PG8_MMA(1, 0, At, B0); PG8_MMA(1, 1, At, B1); PG8_BAR; PG8_SCHED;
            PG8_LDB(B0, 1, 0); PG8_LDB(B1, 1, 1); PG8_SCHED; PG8_LDA(At, 1, 0); PG8_STAGE(PG8_SA(0, 1), a2 + hstep, voffA);
            PG8_WAIT_V(8); PG8_WAIT_L(0); PG8_BAR; PG8_MMA(0, 0, At, B0); PG8_MMA(0, 1, At, B1); PG8_BAR; PG8_SCHED;
            PG8_LDA(At, 1, 1); PG8_STAGE(PG8_SB(1, 0), b3, voffB); PG8_STAGE(PG8_SB(1, 1), b3 + hstep, voffB); PG8_STAGE(PG8_SA(1, 0), a3, voffA);
            PG8_WAIT_V(8); PG8_WAIT_L(0); PG8_BAR; PG8_MMA(1, 0, At, B0); PG8_MMA(1, 1, At, B1); PG8_BAR; PG8_SCHED;
            } else {
            PG8_LDB(B0, 0, 0); PG8_SCHED; PG8_LDA(At, 0, 0); PG8_STAGE(PG8_SA(1, 1), a1 + hstep, voffA);
            PG8_WAIT_L(8); PG8_BAR; PG8_WAIT_L(0); PG8_MMA(0, 0, At, B0); PG8_BAR; PG8_SCHED;
            PG8_LDB(B1, 0, 1); PG8_STAGE(PG8_SB(0, 0), b2, voffB);
            PG8_BAR; PG8_WAIT_L(0); PG8_MMA(0, 1, At, B1); PG8_BAR;
            PG8_LDA(At, 0, 1); PG8_STAGE(PG8_SA(0, 0), a2, voffA);
            PG8_BAR; PG8_WAIT_L(0); PG8_MMA(1, 0, At, B0); PG8_BAR; PG8_SCHED;
            PG8_STAGE(PG8_SB(0, 1), b2 + hstep, voffB);
            PG8_WAIT_V(6); PG8_BAR; PG8_MMA(1, 1, At, B1); PG8_BAR;
            PG8_LDB(B0, 1, 0); PG8_SCHED; PG8_LDA(At, 1, 0); PG8_STAGE(PG8_SA(0, 1), a2 + hstep, voffA);
            PG8_WAIT_L(8); PG8_BAR; PG8_WAIT_L(0); PG8_MMA(0, 0, At, B0); PG8_BAR; PG8_SCHED;
            PG8_LDB(B1, 1, 1); PG8_STAGE(PG8_SB(1, 0), b3, voffB);
            PG8_BAR; PG8_WAIT_L(0); PG8_MMA(0, 1, At, B1); PG8_BAR;
            PG8_LDA(At, 1, 1); PG8_STAGE(PG8_SA(1, 0), a3, voffA);
            PG8_BAR; PG8_WAIT_L(0); PG8_MMA(1, 0, At, B0); PG8_BAR; PG8_SCHED;
            PG8_STAGE(PG8_SB(1, 1), b3 + hstep, voffB);
            PG8_WAIT_V(6); PG8_BAR; PG8_MMA(1, 1, At, B1); PG8_BAR;
            }
        }
        if constexpr (ALIGN_EPI) { if (wr == 0) PG8_BAR; }
        if constexpr (!Epi::AFTER_DRAIN) { E(acc, cur, wr, wc, fr, fq); S.done(cur); }
        if (!has_next) break;
#pragma unroll
        for (int a = 0; a < 2; ++a)
#pragma unroll
            for (int b = 0; b < 2; ++b)
#pragma unroll
                for (int m = 0; m < 4; ++m)
#pragma unroll
                    for (int n = 0; n < 2; ++n) acc[a][b][m][n] = (f32x4){0.f, 0.f, 0.f, 0.f};
        cur = nxt; cA = nA; cB = nB; ++ui;
        if constexpr (ALIGN_EPI) { if (wr == 1) PG8_BAR; }
    }
    PG8_WAIT_V(0);
    if constexpr (!ALIGN_EPI) { if (wr == 0) PG8_BAR; }
    PG8_BAR;
    if constexpr (Epi::AFTER_DRAIN) { E.fused(acc, cur, wr, wc, fr, fq, lds, wid, lane); S.done(cur); }
#undef PG8_SA
#undef PG8_SB
#undef PG8_STAGE
#undef PG8_LDA
#undef PG8_LDB
#undef PG8_MMA
#undef PG8_WAIT_V
#undef PG8_WAIT_L
#undef PG8_BAR
#undef PG8_SCHED
}
}
#define XB_TMO      128
#define XB_XCNT(j)  (256  + 64 * (j))
#define XB_XSUB(j)  (1280 + 64 * (j))
#define XB_XGEN(j)  (2304 + 64 * (j))
#define XB_TOP      3328
#define XB_TOPGEN   3392
#define XCD_BAR_WORDS 3456
#define XB_SPIN_CAP (1u << 18)
#define LAS __attribute__((address_space(3)))

__device__ __forceinline__ unsigned xb_ld(unsigned* p)              { return __hip_atomic_load(p, __ATOMIC_RELAXED, __HIP_MEMORY_SCOPE_AGENT); }
__device__ __forceinline__ unsigned xb_add(unsigned* p, unsigned v) { return __hip_atomic_fetch_add(p, v, __ATOMIC_RELAXED, __HIP_MEMORY_SCOPE_AGENT); }
__device__ __forceinline__ unsigned xb_xcc_id() { return (unsigned)__builtin_amdgcn_s_getreg((3 << 11) | 20) & 0xFu; }
#define XB_SPIN(cond, bar) do { unsigned _sp = 0; while (cond) { __builtin_amdgcn_s_sleep(1); \
    if ((++_sp & 255u) == 0u) { if (xb_ld(&(bar)[XB_TMO])) break; if (_sp > XB_SPIN_CAP) { atomicAdd(&(bar)[XB_TMO], 1u); break; } } } } while (0)

struct XcdBarrier {
    unsigned* bar; unsigned x;
    volatile LAS unsigned* st;
};

__device__ __forceinline__ XcdBarrier xcd_barrier_post(unsigned* bar, volatile LAS unsigned* st) {
    XcdBarrier b; b.bar = bar; b.x = xb_xcc_id(); b.st = st;
    if (threadIdx.x == 0) (void)xb_add(&bar[XB_XCNT(b.x)], 1u);
    return b;
}
__device__ __forceinline__ void xcd_barrier_complete(unsigned* bar, unsigned x, unsigned& nloc, unsigned& nx) {
    const unsigned G = gridDim.x * gridDim.y * gridDim.z;
    unsigned sum, cnt, mine, sp = 0u;
    for (;;) {
        sum = 0u; cnt = 0u; mine = 0u;
#pragma unroll
        for (unsigned j = 0; j < 16; ++j) { const unsigned c = xb_ld(&bar[XB_XCNT(j)]); sum += c; cnt += (c > 0u) ? 1u : 0u; mine = (j == x) ? c : mine; }
        if (sum == G) break;
        __builtin_amdgcn_s_sleep(1);
        if ((++sp & 255u) == 0u) { if (xb_ld(&bar[XB_TMO])) break; if (sp > XB_SPIN_CAP) { atomicAdd(&bar[XB_TMO], 1u); break; } }
    }
    nloc = mine > 0u ? mine : 1u; nx = cnt > 0u ? cnt : 1u;
}

__device__ __forceinline__ void xcd_barrier(const XcdBarrier& b) {
    asm volatile("s_waitcnt vmcnt(0)" ::: "memory");
    __syncthreads();
    if (threadIdx.x == 0) {
        unsigned* bar = b.bar;
        __builtin_amdgcn_s_waitcnt(0);
        unsigned nloc = b.st[0], nx = b.st[1];
        if (nloc == 0u) { xcd_barrier_complete(bar, b.x, nloc, nx); b.st[0] = nloc; b.st[1] = nx; }
        const unsigned old = xb_add(&bar[XB_XSUB(b.x)], 1u);
        const unsigned gen = old / nloc;
        if (old + 1u == (gen + 1u) * nloc) {
            __builtin_amdgcn_fence(__ATOMIC_RELEASE, "agent");
            asm volatile("s_waitcnt vmcnt(0)" ::: "memory");
            const unsigned og = xb_add(&bar[XB_TOP], 1u);
            const unsigned tg = og / nx;
            if (og + 1u == (tg + 1u) * nx) xb_add(&bar[XB_TOPGEN], 1u);
            else XB_SPIN(xb_ld(&bar[XB_TOPGEN]) == tg, bar);
            __builtin_amdgcn_fence(__ATOMIC_ACQUIRE, "agent");
            xb_add(&bar[XB_XGEN(b.x)], 1u);
            asm volatile("s_waitcnt vmcnt(0)" ::: "memory");
        } else {
            XB_SPIN(xb_ld(&bar[XB_XGEN(b.x)]) == gen, bar);
            __builtin_amdgcn_fence(__ATOMIC_ACQUIRE, "agent");
            asm volatile("s_waitcnt vmcnt(0)" ::: "memory");
        }
    }
    __syncthreads();
}
#define GAS __attribute__((address_space(1)))
typedef unsigned short bf16;
typedef float v4f __attribute__((ext_vector_type(4)));
typedef float v2f __attribute__((ext_vector_type(2)));
typedef float v16f __attribute__((ext_vector_type(16)));
typedef short b8 __attribute__((ext_vector_type(8)));
typedef unsigned v4u __attribute__((ext_vector_type(4)));
typedef unsigned v2u __attribute__((ext_vector_type(2)));
#define LDS_WAIT() asm volatile("s_waitcnt lgkmcnt(0)" ::: "memory")
#define MFMA32(a, b, c) __builtin_amdgcn_mfma_f32_32x32x16_bf16((a), (b), (c), 0, 0, 0)
#define MFMA16(a, b, c) __builtin_amdgcn_mfma_f32_16x16x32_bf16((a), (b), (c), 0, 0, 0)

using pg8::MODW;
constexpr int NWAVES = 8, NTHR = 512;
constexpr int D = 2048, DFF = 5632, ML = 8192, MC = 512, MT = 8704;
constexpr float RMS_EPS = 1e-6f;
#ifndef MK_ONE_LAUNCH
#define MK_ONE_LAUNCH 1
#endif
constexpr int NPHASES = 42;
#ifndef KSPLIT
#define KSPLIT 16
#endif
#ifndef PROBE_GU
#define PROBE_GU 0
#endif
#ifndef PROBE_DOWN
#define PROBE_DOWN 0
#endif
#ifndef PROBE_P0
#define PROBE_P0 0
#endif
#ifndef PROBE_ATTN
#define PROBE_ATTN 0
#endif
#ifndef PROBE_SCAN
#define PROBE_SCAN 0
#endif
#ifndef PROBE_SPAT
#define PROBE_SPAT 0
#endif
#ifndef PROBE_NORM
#define PROBE_NORM 0
#endif
#ifndef PROBE_BAR
#define PROBE_BAR 0
#endif
#ifndef NO_ATTN
#define NO_ATTN 0
#endif
#ifndef NO_SCAN
#define NO_SCAN 0
#endif
#ifndef NO_SPAT
#define NO_SPAT 0
#endif
#ifndef NO_P0
#define NO_P0 0
#endif

constexpr size_t MiB = 1u << 20;
constexpr size_t WS_CTL = 0;
constexpr size_t WS_VSS = 1 * MiB;
constexpr size_t WS_QKSS = 1 * MiB + 128 * 1024;
constexpr size_t WS_MOD = 3 * MiB;
constexpr size_t ZERO_BYTES = 4 * MiB;
constexpr size_t WS_HC = 4 * MiB;
constexpr size_t WS_XN = 8 * MiB;
constexpr size_t WS_ACT = 42 * MiB;
constexpr size_t WS_Y = 144 * MiB;
constexpr size_t WS_SLAB = 913 * MiB;
constexpr size_t WS_WGU = 280 * MiB, WS_WDN = 632 * MiB, WS_AWIN = 808 * MiB, WS_AWOUT = 840 * MiB, WS_AWS = 856 * MiB;
constexpr size_t WS_BQKV = 857 * MiB, WS_BWO = 881 * MiB, WS_CWIN = 889 * MiB, WS_CGLU = 897 * MiB, WS_END = 977 * MiB;
constexpr int CW_BAR = 4096, BAR_STRIDE = 3584;
static_assert((CW_BAR + 48 * BAR_STRIDE) * 4 <= (int)MiB, "ctl");
constexpr int LDS_BYTES = 147456;
constexpr int MISC_OFF = 131072 + 320;

__device__ __forceinline__ float bf2f(unsigned short b) { return __uint_as_float(((unsigned)b) << 16); }
__device__ __forceinline__ unsigned pk_bf16(float lo, float hi) { return pg8::cvt_pk_bf16(lo, hi); }
__device__ __forceinline__ unsigned pk_bf16_m(float lo, float hi) { unsigned r; asm volatile("v_cvt_pk_bf16_f32 %0, %1, %2\n\ts_nop 1" : "=v"(r) : "v"(lo), "v"(hi)); return r; }
__device__ __forceinline__ float wave_sum(float v) {
#pragma unroll
    for (int o = 1; o < 64; o <<= 1) v += __shfl_xor(v, o);
    return v;
}

#define OPAQUE_V(x) asm volatile("" : "+v"(x))
struct Args { const float* in[29]; float* out; unsigned char* ws; int ph_lo, ph_hi, li, pad; };

__device__ __forceinline__ void tr_item(const float* W, int K, int N, bf16* WT, int nh, int item, LAS float* scr, int lane) {
    const int nblk = N / 32, kb = item / nblk, nb = item - kb * nblk, k0 = 64 * kb, n0 = 32 * nb;
    int drow0 = n0; if (nh) { const int half = n0 >= nh ? 1 : 0, c = n0 - half * nh; drow0 = 256 * (c >> 7) + 128 * half + (c & 127); }
    const float* src = W + (size_t)k0 * N + n0 + (lane & 31) + (size_t)(lane >> 5) * N;
#pragma unroll 8
    for (int i = 0; i < 32; ++i) scr[(2 * i + (lane >> 5)) * 33 + (lane & 31)] = src[(size_t)(2 * i) * N];
    LDS_WAIT(); asm volatile("" ::: "memory");
    const int c = lane & 7;
#pragma unroll
    for (int j = 0; j < 4; ++j) { const int n = (lane >> 3) + 8 * j; const LAS float* s = scr + (8 * c) * 33 + n;
        v4u o; o.x = pk_bf16(s[0 * 33], s[1 * 33]); o.y = pk_bf16(s[2 * 33], s[3 * 33]); o.z = pk_bf16(s[4 * 33], s[5 * 33]); o.w = pk_bf16(s[6 * 33], s[7 * 33]);
        *(v4u*)(WT + (size_t)(drow0 + n) * K + k0 + 8 * c) = o; }
    LDS_WAIT(); asm volatile("" ::: "memory");
}
__device__ __forceinline__ void p0_prologue(const Args& a, LAS unsigned char* lds, int gw, int NGW, int tid, int lane, int wave, int it0) {
    OPAQUE_V(tid); OPAQUE_V(lane);
    LAS float* sl = (LAS float*)(lds + 73728);
    for (int i = tid; i < 3 * 2048; i += NTHR) { const float v = i < 4096 ? a.in[1][i] : a.in[3][i - 4096]; sl[i] = v / (1.0f + __expf(-v)); }
    __syncthreads();
    LAS float* scr = (LAS float*)(lds + wave * 8704);
    unsigned char* ws = a.ws;
    constexpr int I_ADA = 4 * 72 * 16, I_GU = 32 * 352, I_DN = 88 * 64, I_AIN = 32 * 128, I_SQ = 32 * 64, I_QKV = 32 * 192, I_WS = 256, I_HC = 256;
    constexpr int NITEMS = I_ADA + 8 * I_GU + 8 * I_DN + 2 * I_AIN + 2 * I_SQ + I_QKV + I_SQ + I_SQ + I_AIN + I_WS + I_HC;
    for (int it = gw + it0; it < NITEMS; it += NGW) {
        int r = it;
        if (r < I_ADA) {
            const int layer = r / 1152, rr = r - layer * 1152, cb = rr >> 4, ks = rr & 15, n0 = cb * 256 + lane * 4, k0 = ks * 128;
            const float* Wp = a.in[4] + (size_t)layer * 2048 * MODW + (size_t)k0 * MODW + n0;
            v4f a0 = {0.f, 0.f, 0.f, 0.f}, a1 = a0, a2 = a0;
#pragma unroll 8
            for (int k = 0; k < 128; ++k) { const v4f w = *(const v4f*)(Wp + (size_t)k * MODW); a0 += w * sl[k0 + k]; a1 += w * sl[2048 + k0 + k]; a2 += w * sl[4096 + k0 + k]; }
            if (ks == 0) { const v4f bv = *(const v4f*)(a.in[5] + (size_t)layer * MODW + n0); a0 += bv; a1 += bv; a2 += bv; }
            float* mp = (float*)(ws + WS_MOD) + (size_t)layer * 3 * MODW + n0;
#pragma unroll
            for (int j = 0; j < 4; ++j) { unsafeAtomicAdd(mp + j, a0[j]); unsafeAtomicAdd(mp + MODW + j, a1[j]); unsafeAtomicAdd(mp + 2 * MODW + j, a2[j]); }
            continue; }
        r -= I_ADA;
        if (r < 8 * I_GU) { const int f = r / I_GU; tr_item(a.in[7] + (size_t)f * 2048 * 11264, 2048, 11264, (bf16*)(ws + WS_WGU) + (size_t)f * 11264 * 2048, 5632, r - f * I_GU, scr, lane); continue; } r -= 8 * I_GU;
        if (r < 8 * I_DN) { const int f = r / I_DN; tr_item(a.in[8] + (size_t)f * 5632 * 2048, 5632, 2048, (bf16*)(ws + WS_WDN) + (size_t)f * 2048 * 5632, 0, r - f * I_DN, scr, lane); continue; } r -= 8 * I_DN;
        if (r < 2 * I_AIN) { const int j = r / I_AIN; tr_item(a.in[9] + (size_t)j * 2048 * 4096, 2048, 4096, (bf16*)(ws + WS_AWIN) + (size_t)j * 4096 * 2048, 0, r - j * I_AIN, scr, lane); continue; } r -= 2 * I_AIN;
        if (r < 2 * I_SQ) { const int j = r / I_SQ; tr_item(a.in[13] + (size_t)j * 2048 * 2048, 2048, 2048, (bf16*)(ws + WS_AWOUT) + (size_t)j * 2048 * 2048, 0, r - j * I_SQ, scr, lane); continue; } r -= 2 * I_SQ;
        if (r < I_QKV) { tr_item(a.in[14], 2048, 6144, (bf16*)(ws + WS_BQKV), 0, r, scr, lane); continue; } r -= I_QKV;
        if (r < I_SQ) { tr_item(a.in[18], 2048, 2048, (bf16*)(ws + WS_BWO), 0, r, scr, lane); continue; } r -= I_SQ;
        if (r < I_SQ) { tr_item(a.in[19], 2048, 2048, (bf16*)(ws + WS_CWIN), 0, r, scr, lane); continue; } r -= I_SQ;
        if (r < I_AIN) { tr_item(a.in[28], 2048, 4096, (bf16*)(ws + WS_CGLU), 2048, r, scr, lane); continue; } r -= I_AIN;
        if (r >= I_WS) { r -= I_WS; const v4f* s = (const v4f*)(a.in[2] + (size_t)r * 4096) + lane; v4f* d = (v4f*)((float*)(ws + WS_HC) + (size_t)r * 4096) + lane;
#pragma unroll
          for (int j = 0; j < 16; ++j) d[64 * j] = s[64 * j];
          continue; }
        { const float* s = a.in[11] + (size_t)r * 2048 + lane * 4; bf16* d = (bf16*)(ws + WS_AWS) + (size_t)r * 2048 + lane * 4;
#pragma unroll
          for (int j = 0; j < 8; ++j) { const v4f v = *(const v4f*)(s + 256 * j); v2u o; o.x = pk_bf16(v[0], v[1]); o.y = pk_bf16(v[2], v[3]); *(v2u*)(d + 256 * j) = o; } }
    }
}

__device__ __forceinline__ void ctx_rows(float* hctx, const float* slab, const float* gain, const float* modl, int s, bf16* xn, LAS unsigned char* lds, int blk, int G, int tid, int lane, int wave) {
    LAS float* red = (LAS float*)(lds + 131072 + 1024);
    const v4f* sh = (const v4f*)(modl + 2 * MODW + (3 * s) * D) + tid; const v4f* sc = sh + D / 4; const v4f gn = ((const v4f*)gain)[tid];
    for (int cr = blk; cr < MC; cr += G) {
        v4f* xr = (v4f*)(hctx + (size_t)cr * D) + tid;
        v4f v = *xr;
        if (slab) { v4f pv[KSPLIT];
#pragma unroll
            for (int sl = 0; sl < KSPLIT; ++sl) pv[sl] = ((const v4f*)(slab + ((size_t)sl * MC + cr) * D))[tid];
#pragma unroll
            for (int sl = 0; sl < KSPLIT; ++sl) v += pv[sl];
            *xr = v; }
        const float ss = wave_sum((v[0] * v[0] + v[1] * v[1]) + (v[2] * v[2] + v[3] * v[3]));
        __syncthreads();
        if (lane == 0) red[wave] = ss;
        __syncthreads();
        float tot = 0.f;
#pragma unroll
        for (int w = 0; w < NWAVES; ++w) tot += red[w];
        const float r = rsqrtf(tot * (1.0f / D) + RMS_EPS);
        const v4f y = v * r * gn * (*sc + 1.0f) + *sh; v2u w2; w2.x = pk_bf16(y[0], y[1]); w2.y = pk_bf16(y[2], y[3]);
        ((v2u*)(xn + (size_t)(ML + cr) * D))[tid] = w2;
    }
}
__device__ __forceinline__ void norm_phase(const float* hlat, float* hctx, const float* slab, const float* gain, const float* modl, int s, bf16* xn, int M, LAS unsigned char* lds, int blk, int G, int gw, int NGW, int tid, int lane, int wave) {
    OPAQUE_V(lane); OPAQUE_V(tid);
    for (int row = gw; row < ML; row += NGW) {
        const int cls = row >> 12;
        const v4f* xr = (const v4f*)(hlat + (size_t)row * D) + lane;
        const v4f* sh = (const v4f*)(modl + cls * MODW + (3 * s) * D) + lane; const v4f* sc = sh + D / 4; const v4f* gn = (const v4f*)gain + lane;
        v4f v[8]; float ss = 0.f;
#pragma unroll
        for (int j = 0; j < 8; ++j) { v[j] = xr[64 * j]; ss += (v[j][0] * v[j][0] + v[j][1] * v[j][1]) + (v[j][2] * v[j][2] + v[j][3] * v[j][3]); }
        const float r = rsqrtf(wave_sum(ss) * (1.0f / D) + RMS_EPS);
        v2u* o = (v2u*)(xn + (size_t)row * D) + lane;
#pragma unroll
        for (int j = 0; j < 8; ++j) { const v4f y = v[j] * r * gn[64 * j] * (sc[64 * j] + 1.0f) + sh[64 * j]; v2u w; w.x = pk_bf16(y[0], y[1]); w.y = pk_bf16(y[2], y[3]); o[64 * j] = w; }
    }
    if (M > ML) ctx_rows(hctx, slab, gain, modl, s, xn, lds, blk, G, tid, lane, wave);
}

__device__ __forceinline__ void spatial_phase(const bf16* uv, const float* vss, const bf16* wsb, const float* vgain, const float* bsg, bf16* su, int nchunk,
                                              LAS unsigned char* lds, int gw, int NGW, int lane, int wave) {
    OPAQUE_V(lane);
    LAS float* rq = (LAS float*)(lds + wave * 512);
    const int h = lane >> 5, r32 = lane & 31;
    for (int item = gw; item < nchunk * 64; item += NGW) {
        const int cb = item & 3, g = (item >> 2) & 15, ch = item >> 6, row0 = ch * 128;
        rq[lane] = rsqrtf(vss[row0 + lane] * (1.0f / D) + RMS_EPS); rq[64 + lane] = rsqrtf(vss[row0 + 64 + lane] * (1.0f / D) + RMS_EPS);
        const bf16* vp = uv + (size_t)row0 * 4096 + 2048 + 128 * g + 32 * cb + r32 + (size_t)(8 * h) * 4096;
        unsigned short raw[64];
#pragma unroll
        for (int s = 0; s < 8; ++s)
#pragma unroll
            for (int j = 0; j < 8; ++j) raw[8 * s + j] = vp[(size_t)(16 * s + j) * 4096];
        LDS_WAIT(); asm volatile("" ::: "memory");
        b8 Af[8];
#pragma unroll
        for (int s = 0; s < 8; ++s) { const v4f q0 = *(const LAS v4f*)(rq + 16 * s + 8 * h), q1 = *(const LAS v4f*)(rq + 16 * s + 8 * h + 4);
            v4u w; w.x = pk_bf16_m(bf2f(raw[8 * s + 0]) * q0[0], bf2f(raw[8 * s + 1]) * q0[1]); w.y = pk_bf16_m(bf2f(raw[8 * s + 2]) * q0[2], bf2f(raw[8 * s + 3]) * q0[3]);
            w.z = pk_bf16_m(bf2f(raw[8 * s + 4]) * q1[0], bf2f(raw[8 * s + 5]) * q1[1]); w.w = pk_bf16_m(bf2f(raw[8 * s + 6]) * q1[2], bf2f(raw[8 * s + 7]) * q1[3]); Af[s] = __builtin_bit_cast(b8, w); }
        v16f acc[4];
#pragma unroll
        for (int pb = 0; pb < 4; ++pb) {
#pragma unroll
            for (int i = 0; i < 16; ++i) acc[pb][i] = 0.f;
            const bf16* wp = wsb + ((size_t)g * 128 + 32 * pb + r32) * 128 + 8 * h;
#pragma unroll
            for (int s = 0; s < 8; ++s) { const b8 Bf = *(const b8*)(wp + 16 * s); acc[pb] = MFMA32(Af[s], Bf, acc[pb]); } }
#pragma unroll
        for (int pb = 0; pb < 4; ++pb) { const int p = 32 * pb + r32; const float bsp = bsg[g * 128 + p]; const size_t row = (size_t)(row0 + p);
#pragma unroll
            for (int i4 = 0; i4 < 4; ++i4) { const int cc = 128 * g + 32 * cb + 8 * i4 + 4 * h; const v4f vg = *(const v4f*)(vgain + cc);
                const v2u uu = *(const v2u*)(uv + row * 4096 + cc);
                const float u0 = __uint_as_float(uu.x << 16), u1 = __uint_as_float(uu.x & 0xffff0000u), u2 = __uint_as_float(uu.y << 16), u3 = __uint_as_float(uu.y & 0xffff0000u);
                v2u w; w.x = pk_bf16(u0 * (acc[pb][4 * i4 + 0] * vg[0] + bsp), u1 * (acc[pb][4 * i4 + 1] * vg[1] + bsp)); w.y = pk_bf16(u2 * (acc[pb][4 * i4 + 2] * vg[2] + bsp), u3 * (acc[pb][4 * i4 + 3] * vg[3] + bsp));
                *(v2u*)(su + row * D + cc) = w; } }
    }
}

__device__ __forceinline__ void attn_phase(const bf16* qkv, const float* qkss, const float* qgain, const float* kgain, const float* rpb, bf16* o, int gw, int NGW, int lane) {
    OPAQUE_V(lane);
    const int h = lane >> 5, r32 = lane & 31;
    constexpr int NU_LAT = 2 * 16 * 64 * 2, NU_CTX = 2 * 16 * 8;
    for (int wu = gw; wu < NU_LAT + NU_CTX; wu += NGW) {
        const bool lat = wu < NU_LAT;
        int b, hd, qrow, r = 0, qh = 0, rstart = 0;
        if (lat) { qh = wu & 1; r = (wu >> 1) & 63; hd = (wu >> 7) & 15; b = wu >> 11; qrow = b * 4096 + r * 64 + 32 * qh + r32; rstart = r - 4 < 0 ? 0 : (r - 4 > 56 ? 56 : r - 4); }
        else { const int w = wu - NU_LAT; hd = (w >> 3) & 15; b = w >> 7; qrow = ML + b * 256 + 32 * (w & 7) + r32; }
        const float rqv = rsqrtf(qkss[(size_t)hd * MT + qrow] * (1.0f / 128.0f) + RMS_EPS) * 0.08838834764831845f;
        const bf16* qp = qkv + (size_t)qrow * 6144 + 128 * hd + 8 * h;
        b8 Qf[8];
#pragma unroll
        for (int s = 0; s < 8; ++s) { const v4u raw = *(const v4u*)(qp + 16 * s); const int d0 = 16 * s + 8 * h;
            const v4f g0 = *(const v4f*)(qgain + d0), g1 = *(const v4f*)(qgain + d0 + 4), k0 = *(const v4f*)(kgain + d0), k1 = *(const v4f*)(kgain + d0 + 4);
            v4u w;
            w.x = pk_bf16_m(__uint_as_float(raw.x << 16) * rqv * g0[0] * k0[0], __uint_as_float(raw.x & 0xffff0000u) * rqv * g0[1] * k0[1]);
            w.y = pk_bf16_m(__uint_as_float(raw.y << 16) * rqv * g0[2] * k0[2], __uint_as_float(raw.y & 0xffff0000u) * rqv * g0[3] * k0[3]);
            w.z = pk_bf16_m(__uint_as_float(raw.z << 16) * rqv * g1[0] * k1[0], __uint_as_float(raw.z & 0xffff0000u) * rqv * g1[1] * k1[1]);
            w.w = pk_bf16_m(__uint_as_float(raw.w << 16) * rqv * g1[2] * k1[2], __uint_as_float(raw.w & 0xffff0000u) * rqv * g1[3] * k1[3]);
            Qf[s] = __builtin_bit_cast(b8, w); }
        v16f Oacc[4];
#pragma unroll
        for (int db = 0; db < 4; ++db)
#pragma unroll
            for (int i = 0; i < 16; ++i) Oacc[db][i] = 0.f;
        float lsum = 0.f;
        const int ntile = lat ? 24 : 8, qc = 32 * qh + r32, cstart = qc - 8 < 0 ? 0 : (qc - 8 > 48 ? 48 : qc - 8);
        for (int kt = 0; kt < ntile; ++kt) {
            const bool win = lat && kt < 16;
            const int krow0 = win ? b * 4096 + 64 * rstart + 32 * kt : ML + b * 256 + 32 * (lat ? kt - 16 : kt);
            const bf16* kp = qkv + (size_t)(krow0 + r32) * 6144 + 2048 + 128 * hd + 8 * h;
            v16f sacc;
#pragma unroll
            for (int i = 0; i < 16; ++i) sacc[i] = 0.f;
#pragma unroll
            for (int s = 0; s < 8; ++s) { const b8 Kf = *(const b8*)(kp + 16 * s); sacc = MFMA32(Kf, Qf[s], sacc); }
            const float* rkp = qkss + (size_t)(16 + hd) * MT + krow0 + 4 * h;
            const float* bp = rpb + (size_t)(hd * 15 + (rstart + (kt >> 1) - r + 7)) * 31 + 15 - qc + 32 * (kt & 1);
            float p[16];
#pragma unroll
            for (int i4 = 0; i4 < 4; ++i4) { const v4f rk = *(const v4f*)(rkp + 8 * i4);
#pragma unroll
                for (int j = 0; j < 4; ++j) { const int key = 8 * i4 + 4 * h + j; const float sc = sacc[4 * i4 + j] * rsqrtf(rk[j] * (1.0f / 128.0f) + RMS_EPS);
                    float pv;
                    if (win) { const int kc = 32 * (kt & 1) + key; const bool valid = (unsigned)(kc - cstart) < 16u; const float bias = valid ? bp[key] : 0.f; pv = valid ? __expf(sc + bias) : 0.f; }
                    else pv = __expf(sc);
                    p[4 * i4 + j] = pv; lsum += pv; } }
            const bf16* vp = qkv + (size_t)krow0 * 6144 + 4096 + 128 * hd + r32;
#pragma unroll
            for (int s2 = 0; s2 < 2; ++s2) {
                v4u pw; pw.x = pk_bf16_m(p[8 * s2 + 0], p[8 * s2 + 1]); pw.y = pk_bf16_m(p[8 * s2 + 2], p[8 * s2 + 3]); pw.z = pk_bf16_m(p[8 * s2 + 4], p[8 * s2 + 5]); pw.w = pk_bf16_m(p[8 * s2 + 6], p[8 * s2 + 7]);
                const b8 Pf = __builtin_bit_cast(b8, pw);
#pragma unroll
                for (int db = 0; db < 4; ++db) { b8 Vf;
#pragma unroll
                    for (int j = 0; j < 8; ++j) { const int key = 16 * s2 + 8 * (j >> 2) + 4 * h + (j & 3); Vf[j] = (short)vp[(size_t)key * 6144 + 32 * db]; }
                    Oacc[db] = MFMA32(Vf, Pf, Oacc[db]); } }
        }
        lsum += __shfl_xor(lsum, 32);
        const float inv = 1.0f / lsum;
        bf16* op = o + (size_t)qrow * D + 128 * hd + 4 * h;
#pragma unroll
        for (int db = 0; db < 4; ++db)
#pragma unroll
            for (int i4 = 0; i4 < 4; ++i4) { v2u w; w.x = pk_bf16(Oacc[db][4 * i4 + 0] * inv, Oacc[db][4 * i4 + 1] * inv); w.y = pk_bf16(Oacc[db][4 * i4 + 2] * inv, Oacc[db][4 * i4 + 3] * inv);
                *(v2u*)(op + 32 * db + 8 * i4) = w; }
    }
}

__device__ __forceinline__ void scan_phase(const bf16* ub, const float* a_re, const float* a_im, const float* log_dt, const float* b_re, const float* b_im, const float* c_re, const float* c_im,
                                           float* ybuf, LAS unsigned char* lds, int blk, int G, int wave, int lane) {
    OPAQUE_V(lane);
    if (wave >= 2) return;
    LAS float* BU = (LAS float*)(lds + wave * 32768);
    LAS unsigned char* HS = lds + wave * 32768 + 16384;
    LAS unsigned short* BB = (LAS unsigned short*)(lds + wave * 32768 + 16384 + 8704);
    const int h = lane >> 5, r32 = lane & 31, p = lane, ch = lane & 15, l4 = lane >> 4;
    for (int chain = blk * 2 + wave; chain < 512; chain += 2 * G) {
        const int dir = chain & 1, g = (chain >> 1) & 127, b = chain >> 8, dg = dir * 128 + g;
        const float lr = a_re[(size_t)dg * 64 + p], li = a_im[(size_t)dg * 64 + p], dt = expf(log_dt[dg]);
        const float er = expf(lr * dt), ar = er * cosf(li * dt), ai = er * sinf(li * dt);
        { const float nr = ar - 1.0f, ni = ai, den = 1.0f / (lr * lr + li * li), cr = (nr * lr + ni * li) * den, ci = (ni * lr - nr * li) * den;
          const float* brp = b_re + ((size_t)dg * 64 + p) * 16; const float* bip = b_im + ((size_t)dg * 64 + p) * 16;
#pragma unroll
          for (int c4 = 0; c4 < 4; ++c4) { const v4f br = *(const v4f*)(brp + 4 * c4), bi = *(const v4f*)(bip + 4 * c4);
              v2u wr_, wi_; wr_.x = pk_bf16(cr * br[0] - ci * bi[0], cr * br[1] - ci * bi[1]); wr_.y = pk_bf16(cr * br[2] - ci * bi[2], cr * br[3] - ci * bi[3]);
              wi_.x = pk_bf16(cr * bi[0] + ci * br[0], cr * bi[1] + ci * br[1]); wi_.y = pk_bf16(cr * bi[2] + ci * br[2], cr * bi[3] + ci * br[3]);
              *(LAS v2u*)(BB + (p * 2 + 0) * 16 + 4 * c4) = wr_; *(LAS v2u*)(BB + (p * 2 + 1) * 16 + 4 * c4) = wi_; } }
        LDS_WAIT(); asm volatile("" ::: "memory");
        b8 Bf[4];
#pragma unroll
        for (int cb = 0; cb < 4; ++cb) Bf[cb] = *(const LAS b8*)(BB + ((16 * cb + (r32 >> 1)) * 2 + (r32 & 1)) * 16 + 8 * h);
        b8 Cf[4];
#pragma unroll
        for (int ks = 0; ks < 4; ++ks) { const v4f cre = *(const v4f*)(c_re + ((size_t)dg * 16 + ch) * 64 + 16 * ks + 4 * l4), cim = *(const v4f*)(c_im + ((size_t)dg * 16 + ch) * 64 + 16 * ks + 4 * l4);
            v4u w; w.x = pk_bf16_m(cre[0], -cim[0]); w.y = pk_bf16_m(cre[1], -cim[1]); w.z = pk_bf16_m(cre[2], -cim[2]); w.w = pk_bf16_m(cre[3], -cim[3]); Cf[ks] = __builtin_bit_cast(b8, w); }
        float hr = 0.f, hi = 0.f;
        for (int bi_ = 0; bi_ < 136; ++bi_) {
            int rb, sg;
            if (dir == 0) { rb = bi_ < 8 ? ML + b * 256 + 32 * bi_ : b * 4096 + 32 * (bi_ - 8); sg = 1; }
            else { rb = bi_ < 8 ? ML + b * 256 + 255 - 32 * bi_ : b * 4096 + 4095 - 32 * (bi_ - 8); sg = -1; }
            const b8 Uf = *(const b8*)(ub + (size_t)(rb + sg * r32) * D + 16 * g + 8 * h);
#pragma unroll
            for (int cb = 0; cb < 4; ++cb) { v16f z;
#pragma unroll
                for (int i = 0; i < 16; ++i) z[i] = 0.f;
                const v16f dacc = MFMA32(Uf, Bf[cb], z);
#pragma unroll
                for (int i = 0; i < 16; ++i) BU[((i & 3) + 8 * (i >> 2) + 4 * h) * 128 + 32 * cb + r32] = dacc[i]; }
            LDS_WAIT(); asm volatile("" ::: "memory");
            v2f bu[32];
#pragma unroll
            for (int i = 0; i < 32; ++i) bu[i] = *(const LAS v2f*)(BU + i * 128 + 2 * p);
#pragma unroll
            for (int i = 0; i < 32; ++i) { const float nr = ar * hr - ai * hi + bu[i][0], ni = ar * hi + ai * hr + bu[i][1]; hr = nr; hi = ni;
                *(LAS unsigned*)(HS + i * 272 + 4 * p) = pk_bf16(hr, hi); }
            LDS_WAIT(); asm volatile("" ::: "memory");
#pragma unroll
            for (int tb = 0; tb < 2; ++tb) { v4f ya = {0.f, 0.f, 0.f, 0.f};
#pragma unroll
                for (int ks = 0; ks < 4; ++ks) { const b8 Hf = *(const LAS b8*)(HS + (16 * tb + ch) * 272 + (32 * ks + 8 * l4) * 2); ya = MFMA16(Cf[ks], Hf, ya); }
                const int row = rb + sg * (16 * tb + ch);
                *(v4f*)(ybuf + ((size_t)dir * MT + row) * D + 16 * g + 4 * l4) = ya; }
        }
    }
}
__device__ __forceinline__ void s5post_phase(const bf16* ub, const float* ybuf, const float* cd, bf16* xg, int M, int gw, int NGW, int lane) {
    OPAQUE_V(lane);
    for (int row = gw; row < M; row += NGW) {
        const v2u* up = (const v2u*)(ub + (size_t)row * D) + lane; const v4f* yf = (const v4f*)(ybuf + (size_t)row * D) + lane; const v4f* yr = (const v4f*)(ybuf + ((size_t)MT + row) * D) + lane;
        const v4f* dp = (const v4f*)cd + lane; v2u* o = (v2u*)(xg + (size_t)row * D) + lane;
#pragma unroll
        for (int j = 0; j < 8; ++j) { const v2u uu = up[64 * j]; const v4f d = dp[64 * j], a = yf[64 * j], c = yr[64 * j];
            const float y0 = d[0] * __uint_as_float(uu.x << 16) + a[0] + c[0], y1 = d[1] * __uint_as_float(uu.x & 0xffff0000u) + a[1] + c[1];
            const float y2 = d[2] * __uint_as_float(uu.y << 16) + a[2] + c[2], y3 = d[3] * __uint_as_float(uu.y & 0xffff0000u) + a[3] + c[3];
            v2u w; w.x = pk_bf16(pg8::fgelu(y0), pg8::fgelu(y1)); w.y = pk_bf16(pg8::fgelu(y2), pg8::fgelu(y3)); o[64 * j] = w; }
    }
}

__global__ void __launch_bounds__(NTHR, 2) fwd_kernel(Args a) {
    extern __shared__ __attribute__((aligned(16))) unsigned char lds_raw[];
    LAS unsigned char* lds = (LAS unsigned char*)lds_raw;
    volatile LAS unsigned* MISC = (volatile LAS unsigned*)(lds + MISC_OFF);
    const int tid = threadIdx.x, lane = tid & 63, wave = __builtin_amdgcn_readfirstlane(tid >> 6);
    const int G = gridDim.x, bx = blockIdx.x, vcu = (G % 8 == 0) ? (bx % 8) * (G / 8) + bx / 8 : bx;
    const int gw = vcu * NWAVES + wave, NGW = G * NWAVES;
    for (int u = tid; u < (LDS_BYTES - 131072) / 4; u += NTHR) ((LAS unsigned*)(lds + 131072))[u] = 0u;
    __syncthreads();
    unsigned char* ws = a.ws;
    XcdBarrier bar = xcd_barrier_post((unsigned*)(ws + WS_CTL) + CW_BAR + a.li * BAR_STRIDE, MISC + 8);
    const int lo = a.ph_lo, hi = a.ph_hi;
    int pc = 0;
#define PH_IN (lo <= pc && pc < hi)
#define PH_END() do { if (pc + 1 < hi) { xcd_barrier(bar); for (int pb_ = 0; pb_ < PROBE_BAR; ++pb_) xcd_barrier(bar); } } while (0)
    float* mod = (float*)(ws + WS_MOD); float* hc = (float*)(ws + WS_HC);
    bf16* xn = (bf16*)(ws + WS_XN); bf16* act = (bf16*)(ws + WS_ACT); float* ybuf = (float*)(ws + WS_Y);
    float* vss = (float*)(ws + WS_VSS); float* qkss = (float*)(ws + WS_QKSS); float* slab = (float*)(ws + WS_SLAB);
    bool pend = false;

    if (PH_IN) { p0_prologue(a, lds, gw, NGW, tid, lane, wave, 0); for (int rp = 0; rp < PROBE_P0; ++rp) { xcd_barrier(bar); p0_prologue(a, lds, gw, NGW, tid, lane, wave, 3 * NGW); } PH_END(); } ++pc;

    for (int f = 0; f < 8; ++f) {
        const int layer = f >> 1, sub = f & 1, kind = layer % 3, M = (layer == 3) ? ML : MT;
        const float* modl = mod + (size_t)layer * 3 * MODW;
        const float* hin_l = (f == 0) ? a.in[0] : (const float*)a.out;
        if (PH_IN) { norm_phase(hin_l, hc, pend ? slab : nullptr, a.in[6] + (size_t)(layer * 3 + 2 * sub) * D, modl, 2 * sub, xn, M, lds, bx, G, gw, NGW, tid, lane, wave);
            for (int rp = 0; rp < PROBE_NORM; ++rp) { xcd_barrier(bar); norm_phase(hin_l, hc, nullptr, a.in[6] + (size_t)(layer * 3 + 2 * sub) * D, modl, 2 * sub, xn, M, lds, bx, G, gw, NGW, tid, lane, wave); } PH_END(); } ++pc; pend = false;
        if (PH_IN) { pg8::Gemm g{xn, (const bf16*)(ws + WS_WGU) + (size_t)f * 11264 * 2048, M, 11264, 2048}; pg8::StaticOrder S; S.init(M, 11264, 2048, G, bx);
            pg8::EpiSwiglu E{act, DFF}; for (int rp = 0; rp <= PROBE_GU; ++rp) { if (rp) xcd_barrier(bar); pg8::gemm_phase<pg8::EpiSwiglu, pg8::StaticOrder, true, true>(lds, g, S, E); } PH_END(); } ++pc;
        if (PH_IN) { pg8::Gemm g{act, (const bf16*)(ws + WS_WDN) + (size_t)f * 2048 * 5632, M, 2048, DFF}; pg8::SplitOrder S; S.init(2048, DFF, G, bx, KSPLIT, M > ML);
            pg8::EpiRes E{hin_l, hc, a.out, hc, modl + (6 * sub + 2) * D, slab, 0.5f};
            for (int rp = 0; rp < PROBE_DOWN; ++rp) { pg8::EpiRes E2{hin_l, hc, ybuf, ybuf, modl + (6 * sub + 2) * D, ybuf + 17 * 1024 * 1024, 0.5f}; pg8::gemm_phase<pg8::EpiRes, pg8::SplitOrder, true, true>(lds, g, S, E2); xcd_barrier(bar); }
            pg8::gemm_phase<pg8::EpiRes, pg8::SplitOrder, true, true>(lds, g, S, E); PH_END(); } ++pc; pend = M > ML;
        if (sub == 0) {
            const int j = layer / 3;
            if (PH_IN) { norm_phase(a.out, hc, pend ? slab : nullptr, a.in[6] + (size_t)(layer * 3 + 1) * D, modl, 1, xn, M, lds, bx, G, gw, NGW, tid, lane, wave); PH_END(); } ++pc; pend = false;
            if (kind == 0) {
                if (PH_IN) { pg8::Gemm g{xn, (const bf16*)(ws + WS_AWIN) + (size_t)j * 4096 * 2048, M, 4096, 2048}; pg8::StaticOrder S; S.init(M, 4096, 2048, G, bx);
                    pg8::EpiBf<1> E{act, 4096, vss + (size_t)j * MT}; pg8::gemm_phase<pg8::EpiBf<1>, pg8::StaticOrder, true, true>(lds, g, S, E); PH_END(); } ++pc;
                if (PH_IN) { for (int rp = 0; rp <= PROBE_SPAT; ++rp) spatial_phase(act, vss + (size_t)j * MT, (const bf16*)(ws + WS_AWS) + (size_t)j * 16 * 128 * 128, a.in[10] + (size_t)j * D, a.in[12] + (size_t)j * 16 * 128, xn, M / 128, lds, gw, NGW, lane, wave); PH_END(); } ++pc;
            } else if (kind == 1) {
                if (PH_IN) { pg8::Gemm g{xn, (const bf16*)(ws + WS_BQKV), M, 6144, 2048}; pg8::StaticOrder S; S.init(M, 6144, 2048, G, bx);
                    pg8::EpiBf<2> E{act, 6144, qkss}; pg8::gemm_phase<pg8::EpiBf<2>, pg8::StaticOrder, true, true>(lds, g, S, E); PH_END(); } ++pc;
                if (PH_IN) { for (int rp = 0; rp <= PROBE_ATTN; ++rp) attn_phase(act, qkss, a.in[15], a.in[16], a.in[17], xn, gw, NGW, lane); PH_END(); } ++pc;
            } else {
                if (PH_IN) { pg8::Gemm g{xn, (const bf16*)(ws + WS_CWIN), M, 2048, 2048}; pg8::StaticOrder S; S.init(M, 2048, 2048, G, bx);
                    pg8::EpiBf<0> E{act, 2048, nullptr}; pg8::gemm_phase<pg8::EpiBf<0>, pg8::StaticOrder, true, true>(lds, g, S, E); PH_END(); } ++pc;
                if (PH_IN) { for (int rp = 0; rp <= PROBE_SCAN; ++rp) scan_phase(act, a.in[20], a.in[21], a.in[22], a.in[23], a.in[24], a.in[25], a.in[26], ybuf, lds, bx, G, wave, lane); PH_END(); } ++pc;
                if (PH_IN) { s5post_phase(act, ybuf, a.in[27], xn, M, gw, NGW, lane); PH_END(); } ++pc;
            }
            if (kind != 2) {
                if (PH_IN) { const bf16* wo = kind == 0 ? (const bf16*)(ws + WS_AWOUT) + (size_t)j * 2048 * 2048 : (const bf16*)(ws + WS_BWO);
                    pg8::Gemm g{xn, wo, M, 2048, 2048}; pg8::SplitOrder S; S.init(2048, 2048, G, bx, KSPLIT, M > ML);
                    pg8::EpiRes E{a.out, hc, a.out, hc, modl + 5 * D, slab, 1.0f}; pg8::gemm_phase<pg8::EpiRes, pg8::SplitOrder, true, true>(lds, g, S, E); PH_END(); } ++pc; pend = M > ML;
            } else {
                if (PH_IN) { pg8::Gemm g{xn, (const bf16*)(ws + WS_CGLU), M, 4096, 2048}; pg8::StaticOrder S; S.init(M, 4096, 2048, G, bx);
                    pg8::EpiGluRes E{a.out, hc, a.out, hc, modl + 5 * D}; pg8::gemm_phase<pg8::EpiGluRes, pg8::StaticOrder, true, true>(lds, g, S, E); PH_END(); } ++pc;
            }
        }
    }
#undef PH_IN
#undef PH_END
}

extern "C" void kernel_launch(void* const* d_in, const int* in_sizes, int n_in, void* d_out, int out_size, void* d_ws, size_t ws_size, hipStream_t stream) {
    static int grid = 0;
    if (grid == 0) {
        if (n_in != 29 || out_size != ML * D || ws_size < WS_END) { fprintf(stderr, "kernel_launch: unexpected shapes (n_in %d out %d ws %zu)\n", n_in, out_size, ws_size); grid = -1; return; }
        int dev = 0, cus = 0, per_cu = 0;
        if (hipGetDevice(&dev) != hipSuccess || hipDeviceGetAttribute(&cus, hipDeviceAttributeMultiprocessorCount, dev) != hipSuccess) { grid = -1; return; }
        if (hipFuncSetAttribute((const void*)fwd_kernel, hipFuncAttributeMaxDynamicSharedMemorySize, LDS_BYTES) != hipSuccess) { fprintf(stderr, "kernel_launch: hipFuncSetAttribute failed\n"); grid = -1; return; }
        if (hipOccupancyMaxActiveBlocksPerMultiprocessor(&per_cu, (const void*)fwd_kernel, NTHR, LDS_BYTES) != hipSuccess || per_cu < 1) fprintf(stderr, "kernel_launch: occupancy query says %d blocks per CU\n", per_cu);
        (void)hipGetLastError();
        grid = cus;
    }
    if (grid < 0) return;
    if (hipMemsetAsync(d_ws, 0, ZERO_BYTES, stream) != hipSuccess) { fprintf(stderr, "kernel_launch: memset failed\n"); return; }
    Args a{};
    for (int i = 0; i < 29; ++i) a.in[i] = (const float*)d_in[i];
    a.out = (float*)d_out; a.ws = (unsigned char*)d_ws; a.pad = 0;
#if MK_ONE_LAUNCH
    a.ph_lo = 0; a.ph_hi = NPHASES; a.li = 0;
    hipLaunchKernelGGL(fwd_kernel, dim3(grid), dim3(NTHR), LDS_BYTES, stream, a);
#else
    for (int k = 0; k < NPHASES; ++k) { a.ph_lo = k; a.ph_hi = k + 1; a.li = k;
        hipLaunchKernelGGL(fwd_kernel, dim3(grid), dim3(NTHR), LDS_BYTES, stream, a); }
#endif
    const hipError_t le = hipPeekAtLastError();
    if (le != hipSuccess) fprintf(stderr, "kernel_launch: launch failed: %s\n", hipGetErrorName(le));
}
```

```cpp
#include <hip/hip_runtime.h>
#include <cstdio>
#include <cstdint>
namespace pg8 {
#define PG8_LAS __attribute__((address_space(3)))
typedef unsigned short bf16_t;
typedef short bf16x8 __attribute__((ext_vector_type(8)));
typedef float f32x4 __attribute__((ext_vector_type(4)));
typedef unsigned u32x4 __attribute__((ext_vector_type(4)));
constexpr int BM = 256, BK = 64, HALF = 128, HTB = HALF * BK * 2  , STAGE_BYTES = 8 * HTB, NXCD = 8, WGM = 8;

__host__ __device__ __forceinline__ int lds_byte(int r, int c) { const int st = (r >> 4) * 2 + (c >> 5), rr = r & 15, cc = c & 31, ob = rr * 64 + cc * 2; return st * 1024 + (ob ^ (((ob >> 9) & 1) << 5)); }
__host__ __device__ __forceinline__ void stage_rc(int b, int& R, int& C) { const int st = b / 1024, sb = b % 1024, swz = sb ^ (((sb >> 9) & 1) << 5); R = (st >> 1) * 16 + swz / 64; C = (st & 1) * 32 + (swz % 64) / 2; }
__host__ __device__ __forceinline__ int perm32(int rho) { const int n = rho >> 4, i = rho & 15; return 8 * (i >> 2) + 4 * n + (i & 3); }

struct Unit { int pm, pn, kt0, nkt, part; };
struct Gemm { const bf16_t* A; const bf16_t* Bt; int M, N, K; };

struct StaticOrder {
    int nM, nN, nwg, G, c, nkt;
    __host__ __device__ void init(int M, int N, int K, int G_, int c_) { nM = M / BM; nN = N / BM; nwg = nM * nN; G = G_; c = c_; nkt = K / BK; }
    __host__ __device__ bool next(int i, Unit& u) const {
        const long L = (long)i * G + c; if (L >= nwg) return false;
        int wgid = (int)L; { const int q = nwg / NXCD, r = nwg % NXCD, xcd = wgid % NXCD, off = wgid / NXCD; wgid = (xcd < r ? xcd * (q + 1) : r * (q + 1) + (xcd - r) * q) + off; }
        const int nig = WGM * nN, gid = wgid / nig, fm = gid * WGM, gsz = (nM - fm) < WGM ? (nM - fm) : WGM;
        u.pm = fm + ((wgid % nig) % gsz); u.pn = (wgid % nig) / gsz; u.kt0 = 0; u.nkt = nkt; u.part = 0; return true;
    }
    __device__ __forceinline__ void a_ready(const Unit&) const {}
    __device__ __forceinline__ void done(const Unit&) const {}
};
struct SplitOrder {
    StaticOrder lat; int nlat, npiece, nN, nkt, split, G, c;
    __device__ void init(int N, int K, int G_, int c_, int split_, bool has_ctx) { lat.init(8192, N, K, G_, c_); nN = N / BM; nkt = K / BK; split = split_; nlat = 32 * nN; npiece = has_ctx ? 2 * nN * split_ : 0; G = G_; c = c_; }
    __device__ bool next(int i, Unit& u) const {
        const long L = (long)i * G + c;
        if (L < nlat) return lat.next(i, u);
        const int q = (int)(L - nlat); if (q >= npiece) return false;
        const int cu = q / split, s = q - cu * split, PP = nkt >> 1, p0 = s * PP / split, p1 = (s + 1) * PP / split;
        u.pm = 32 + cu / nN; u.pn = cu % nN; u.kt0 = 2 * p0; u.nkt = 2 * (p1 - p0); u.part = 1 + s; return true;
    }
    __device__ __forceinline__ void a_ready(const Unit&) const {}
    __device__ __forceinline__ void done(const Unit&) const {}
};
__device__ __forceinline__ unsigned cvt_pk_bf16(float lo, float hi) { unsigned r; asm volatile("v_cvt_pk_bf16_f32 %0, %1, %2" : "=v"(r) : "v"(lo), "v"(hi)); return r; }
__device__ __forceinline__ float fsigmoid(float x) { return __builtin_amdgcn_rcpf(1.0f + __builtin_amdgcn_exp2f(-1.44269504f * x)); }
__device__ __forceinline__ float fsilu(float x) { return x * fsigmoid(x); }
__device__ __forceinline__ float fgelu(float x) { return x * fsigmoid(1.5957691216f * (x + 0.044715f * x * x * x)); }
constexpr int ROWS_LAT = 8192, ROWS_ALL = 8704, MODW = 9 * 2048;

struct EpiSwiglu {
    static constexpr bool PERM = true, AFTER_DRAIN = false;
    bf16_t* O; int ldc;
    __device__ __forceinline__ void operator()(const f32x4 (&acc)[2][2][4][2], const Unit& u, int wr, int wc, int fr, int fq) const {
        const int row0 = u.pm * BM + wr * 64 + fr, col0 = u.pn * HALF + wc * 32 + 8 * fq;
#pragma unroll
        for (int ai = 0; ai < 2; ++ai)
#pragma unroll
            for (int m = 0; m < 4; ++m) { bf16_t* rowp = O + (size_t)(row0 + ai * HALF + m * 16) * ldc + col0;
                const f32x4 g0 = acc[ai][0][m][0], g1 = acc[ai][0][m][1], u0 = acc[ai][1][m][0], u1 = acc[ai][1][m][1];
                u32x4 w; w.x = cvt_pk_bf16(fsilu(g0[0]) * u0[0], fsilu(g0[1]) * u0[1]); w.y = cvt_pk_bf16(fsilu(g0[2]) * u0[2], fsilu(g0[3]) * u0[3]);
                w.z = cvt_pk_bf16(fsilu(g1[0]) * u1[0], fsilu(g1[1]) * u1[1]); w.w = cvt_pk_bf16(fsilu(g1[2]) * u1[2], fsilu(g1[3]) * u1[3]);
                *(u32x4*)rowp = w; }
    }
};
struct EpiRes {
    static constexpr bool PERM = false, AFTER_DRAIN = false;
    const float* blat; const float* bctx; float* olat; float* octx; const float* gate; float* slab; float f;
    __device__ __forceinline__ void operator()(const f32x4 (&acc)[2][2][4][2], const Unit& u, int wr, int wc, int fr, int fq) const {
        const bool isctx = u.pm >= 32; const int cls = isctx ? 2 : (u.pm >> 4);
        const float* base = isctx ? bctx : blat; float* out = isctx ? octx : olat;
        const int row0 = (isctx ? u.pm - 32 : u.pm) * BM + wr * 64 + fr, col0 = u.pn * BM + wc * 32 + 4 * fq;
        const float* gp = gate + cls * MODW + col0;
        f32x4 gv[2][2];
#pragma unroll
        for (int bj = 0; bj < 2; ++bj)
#pragma unroll
            for (int n = 0; n < 2; ++n) gv[bj][n] = *(const f32x4*)(gp + bj * HALF + n * 16) * f;
#pragma unroll
        for (int ai = 0; ai < 2; ++ai)
#pragma unroll
            for (int m = 0; m < 4; ++m) { const size_t off = (size_t)(row0 + ai * HALF + m * 16) * 2048 + col0;
#pragma unroll
                for (int bj = 0; bj < 2; ++bj)
#pragma unroll
                    for (int n = 0; n < 2; ++n) {
                        if (u.part) *(f32x4*)(slab + (size_t)(u.part - 1) * (512 * 2048) + off + bj * HALF + n * 16) = gv[bj][n] * acc[ai][bj][m][n];
                        else { const f32x4 b = *(const f32x4*)(base + off + bj * HALF + n * 16); *(f32x4*)(out + off + bj * HALF + n * 16) = b + gv[bj][n] * acc[ai][bj][m][n]; } } }
    }
};
struct EpiGluRes {
    static constexpr bool PERM = false, AFTER_DRAIN = false;
    const float* blat; const float* bctx; float* olat; float* octx; const float* gate;
    __device__ __forceinline__ void operator()(const f32x4 (&acc)[2][2][4][2], const Unit& u, int wr, int wc, int fr, int fq) const {
        const bool isctx = u.pm >= 32; const int cls = isctx ? 2 : (u.pm >> 4);
        const float* base = isctx ? bctx : blat; float* out = isctx ? octx : olat;
        const int row0 = (isctx ? u.pm - 32 : u.pm) * BM + wr * 64 + fr, col0 = u.pn * HALF + wc * 32 + 4 * fq;
        const float* gp = gate + cls * MODW + col0;
        f32x4 gv[2];
#pragma unroll
        for (int n = 0; n < 2; ++n) gv[n] = *(const f32x4*)(gp + n * 16);
#pragma unroll
        for (int ai = 0; ai < 2; ++ai)
#pragma unroll
            for (int m = 0; m < 4; ++m) { const size_t off = (size_t)(row0 + ai * HALF + m * 16) * 2048 + col0;
#pragma unroll
                for (int n = 0; n < 2; ++n) { const f32x4 b = *(const f32x4*)(base + off + n * 16); const f32x4 av = acc[ai][0][m][n], gg = acc[ai][1][m][n];
                    f32x4 v; v[0] = av[0] * fsigmoid(gg[0]); v[1] = av[1] * fsigmoid(gg[1]); v[2] = av[2] * fsigmoid(gg[2]); v[3] = av[3] * fsigmoid(gg[3]);
                    *(f32x4*)(out + off + n * 16) = b + gv[n] * v; } }
    }
};
template <int MODE> struct EpiBf {
    static constexpr bool PERM = true, AFTER_DRAIN = false;
    bf16_t* O; int ldc; float* ss;
    __device__ __forceinline__ void operator()(const f32x4 (&acc)[2][2][4][2], const Unit& u, int wr, int wc, int fr, int fq) const {
        const int row0 = u.pm * BM + wr * 64 + fr, col0 = u.pn * BM + wc * 32 + 8 * fq;
#pragma unroll
        for (int ai = 0; ai < 2; ++ai)
#pragma unroll
            for (int m = 0; m < 4; ++m) { const int row = row0 + ai * HALF + m * 16; bf16_t* rowp = O + (size_t)row * ldc + col0; float s1 = 0.f;
#pragma unroll
                for (int bj = 0; bj < 2; ++bj) { f32x4 v0 = acc[ai][bj][m][0], v1 = acc[ai][bj][m][1];
                    if (MODE == 1) {
#pragma unroll
                        for (int j = 0; j < 4; ++j) { v0[j] = fgelu(v0[j]); v1[j] = fgelu(v1[j]); } }
                    u32x4 w; w.x = cvt_pk_bf16(v0[0], v0[1]); w.y = cvt_pk_bf16(v0[2], v0[3]); w.z = cvt_pk_bf16(v1[0], v1[1]); w.w = cvt_pk_bf16(v1[2], v1[3]);
                    *(u32x4*)(rowp + bj * HALF) = w;
                    if (MODE != 0) { float s = (v0[0] * v0[0] + v0[1] * v0[1]) + (v0[2] * v0[2] + v0[3] * v0[3]) + (v1[0] * v1[0] + v1[1] * v1[1]) + (v1[2] * v1[2] + v1[3] * v1[3]);
                        if (MODE == 2) { if (u.pn < 16) { s += __shfl_xor(s, 16); s += __shfl_xor(s, 32); if (fq == 0) unsafeAtomicAdd(ss + (size_t)(2 * u.pn + bj) * ROWS_ALL + row, s); } }
                        else s1 += s; } }
                if (MODE == 1) { if (u.pn >= 8) { s1 += __shfl_xor(s1, 16); s1 += __shfl_xor(s1, 32); if (fq == 0) unsafeAtomicAdd(ss + row, s1); } } }
    }
};

template <class Epi, class Sched, bool ALIGN_EPI = false, bool SP2 = false>
__device__ __forceinline__ void gemm_phase(PG8_LAS unsigned char* lds, const Gemm g, const Sched& S, const Epi& E) {
    int tid_l = threadIdx.x; asm volatile("" : "+v"(tid_l));
    const int tid = tid_l, wid = __builtin_amdgcn_readfirstlane(tid >> 6), lane = tid & 63, wr = wid >> 2, wc = wid & 3, fr = lane & 15, fq = lane >> 4;
    const int K = g.K;
    unsigned voffA[2], voffB[2];
#pragma unroll
    for (int i = 0; i < 2; ++i) { int R, C; stage_rc(tid * 16 + i * 8192, R, C); const int Rb = Epi::PERM ? ((R & ~31) + perm32(R & 31)) : R;
        voffA[i] = (unsigned)(R * K + C) * 2u; voffB[i] = (unsigned)(Rb * K + C) * 2u; }
    const size_t kstep = (size_t)(BK * 2);
    const size_t hstep = (size_t)HALF * K * 2;
    const size_t tstep = 2 * hstep;
    const unsigned ldsw = (unsigned)wid * 1024u;
    const int aoff = lds_byte(wr * 64 + fr, fq * 8), boff = lds_byte(wc * 32 + fr, fq * 8);
#define PG8_SA(b, h) (((b) * 2 + (h)) * HTB)
#define PG8_SB(b, h) ((4 + (b) * 2 + (h)) * HTB)
#define PG8_STAGE(bufoff, gbase, voff) do { _Pragma("unroll") for (int _i = 0; _i < 2; ++_i) \
        __builtin_amdgcn_global_load_lds((const unsigned*)((const char*)(gbase) + (voff)[_i]), (PG8_LAS unsigned*)(lds + (bufoff) + ldsw + _i * 8192), 16, 0, 0); } while (0)
#define PG8_LDA(dst, b, h) do { _Pragma("unroll") for (int m = 0; m < 4; ++m) _Pragma("unroll") for (int k = 0; k < 2; ++k) dst[m][k] = *(const PG8_LAS bf16x8*)(lds + PG8_SA(b, h) + aoff + m * 2048 + k * 1024); } while (0)
#define PG8_LDB(dst, b, h) do { _Pragma("unroll") for (int n = 0; n < 2; ++n) _Pragma("unroll") for (int k = 0; k < 2; ++k) dst[n][k] = *(const PG8_LAS bf16x8*)(lds + PG8_SB(b, h) + boff + n * 2048 + k * 1024); } while (0)
#define PG8_MMA(ai, bj, At, Bt) do { __builtin_amdgcn_s_setprio(1); _Pragma("unroll") for (int m = 0; m < 4; ++m) _Pragma("unroll") for (int n = 0; n < 2; ++n) _Pragma("unroll") for (int k = 0; k < 2; ++k) \
        acc[ai][bj][m][n] = __builtin_amdgcn_mfma_f32_16x16x32_bf16(Bt[n][k], At[m][k], acc[ai][bj][m][n], 0, 0, 0); __builtin_amdgcn_s_setprio(0); } while (0)
#define PG8_WAIT_V(n) asm volatile("s_waitcnt vmcnt(" #n ")" ::: "memory")
#define PG8_WAIT_L(n) asm volatile("s_waitcnt lgkmcnt(" #n ")" ::: "memory")
#define PG8_BAR __builtin_amdgcn_s_barrier()
#define PG8_SCHED __builtin_amdgcn_sched_barrier(0)
    Unit cur, nxt; int ui = 0;
    if (!S.next(0, cur)) return;
    f32x4 acc[2][2][4][2];
#pragma unroll
    for (int a = 0; a < 2; ++a)
#pragma unroll
        for (int b = 0; b < 2; ++b)
#pragma unroll
            for (int m = 0; m < 4; ++m)
#pragma unroll
                for (int n = 0; n < 2; ++n) acc[a][b][m][n] = (f32x4){0.f, 0.f, 0.f, 0.f};
    bf16x8 At[4][2], B0[2][2], B1[2][2];
    const char* cA = (const char*)g.A + (size_t)cur.pm * tstep + (size_t)cur.kt0 * kstep; const char* cB = (const char*)g.Bt + (size_t)cur.pn * tstep + (size_t)cur.kt0 * kstep;
    S.a_ready(cur);
    if constexpr (SP2) {
        PG8_STAGE(PG8_SB(0, 0), cB, voffB); PG8_STAGE(PG8_SB(0, 1), cB + hstep, voffB); PG8_STAGE(PG8_SA(0, 0), cA, voffA); PG8_STAGE(PG8_SA(0, 1), cA + hstep, voffA);
        if (wr == 1) PG8_BAR;
        PG8_WAIT_V(2); PG8_BAR;
        PG8_STAGE(PG8_SB(1, 0), cB + kstep, voffB); PG8_STAGE(PG8_SA(1, 0), cA + kstep, voffA); PG8_STAGE(PG8_SB(1, 1), cB + hstep + kstep, voffB);
        PG8_WAIT_V(6); PG8_BAR;
    } else {
        PG8_STAGE(PG8_SB(0, 0), cB, voffB); PG8_STAGE(PG8_SA(0, 0), cA, voffA); PG8_STAGE(PG8_SB(0, 1), cB + hstep, voffB); PG8_STAGE(PG8_SA(0, 1), cA + hstep, voffA);
        if (wr == 1) PG8_BAR;
        PG8_WAIT_V(4); PG8_BAR;
        PG8_STAGE(PG8_SB(1, 0), cB + kstep, voffB); PG8_STAGE(PG8_SA(1, 0), cA + kstep, voffA); PG8_STAGE(PG8_SB(1, 1), cB + hstep + kstep, voffB);
        PG8_WAIT_V(6); PG8_BAR;
    }
    for (;;) {
        const bool has_next = S.next(ui + 1, nxt);
        const char* nA = has_next ? (const char*)g.A + (size_t)nxt.pm * tstep + (size_t)nxt.kt0 * kstep : cA; const char* nB = has_next ? (const char*)g.Bt + (size_t)nxt.pn * tstep + (size_t)nxt.kt0 * kstep : cB;
        const int nt = cur.nkt;
        for (int t = 0; t < nt; t += 2) {
            const bool last = (t == nt - 2);
            const char* a1 = cA + (size_t)(t + 1) * kstep;
            const char* a2 = last ? nA : cA + (size_t)(t + 2) * kstep; const char* b2 = last ? nB : cB + (size_t)(t + 2) * kstep;
            const char* a3 = a2 + kstep; const char* b3 = b2 + kstep;
            if (last && has_next) S.a_ready(nxt);
            if constexpr (SP2) {
            PG8_LDB(B0, 0, 0); PG8_LDB(B1, 0, 1); PG8_SCHED; PG8_LDA(At, 0, 0); PG8_STAGE(PG8_SA(1, 1), a1 + hstep, voffA);
            PG8_WAIT_V(8); PG8_WAIT_L(0); PG8_BAR; PG8_MMA(0, 0, At, B0); PG8_MMA(0, 1, At, B1); PG8_BAR; PG8_SCHED;
            PG8_LDA(At, 0, 1); PG8_STAGE(PG8_SB(0, 0), b2, voffB); PG8_STAGE(PG8_SB(0, 1), b2 + hstep, voffB); PG8_STAGE(PG8_SA(0, 0), a2, voffA);
            PG8_WAIT_V(8); PG8_WAIT_L(0); PG8_BAR; PG8_MMA(1, 0, At, B0); PG8_MMA(1, 1, At, B1); PG8_BAR; PG8_SCHED;
            PG8_LDB(B0, 1, 0); PG8_LDB(B1, 1, 1); PG8_SCHED; PG8_LDA(At, 1, 0); PG8_STAGE(PG8_SA(0, 1), a2 + hstep, voffA);
            PG8_WAIT_V(8); PG8_WAIT_L(0); PG8_BAR; PG8_MMA(0, 0, At, B0); PG8_MMA(0, 1, At, B1); PG8_BAR; PG8_SCHED;
            PG8_LDA(At, 1, 1); PG8_STAGE(PG8_SB(1, 0), b3, voffB); PG8_STAGE(PG8_SB(1, 1), b3 + hstep, voffB); PG8_STAGE(PG8_SA(1, 0), a3, voffA);
            PG8_WAIT_V(8); PG8_WAIT_L(0); PG8_BAR; PG8_MMA(1, 0, At, B0); PG8_MMA(1, 1, At, B1); PG8_BAR; PG8_SCHED;
            } else {
            PG8_LDB(B0, 0, 0); PG8_SCHED; PG8_LDA(At, 0, 0); PG8_STAGE(PG8_SA(1, 1), a1 + hstep, voffA);
            PG8_WAIT_L(8); PG8_BAR; PG8_WAIT_L(0); PG8_MMA(0, 0, At, B0); PG8_BAR; PG8_SCHED;
            PG8_LDB(B1, 0, 1); PG8_STAGE(PG8_SB(0, 0), b2, voffB);
            PG8_BAR; PG8_WAIT_L(0); PG8_MMA(0, 1, At, B1); PG8_BAR;
            PG8_LDA(At, 0, 1); PG8_STAGE(PG8_SA(0, 0), a2, voffA);
            PG8_BAR; PG8_WAIT_L(0); PG8_MMA(1, 0, At, B0); PG8_BAR; PG8_SCHED;
            PG8_STAGE(PG8_SB(0, 1), b2 + hstep, voffB);
            PG8_WAIT_V(6); PG8_BAR; PG8_MMA(1, 1, At, B1); PG8_BAR;
            PG8_LDB(B0, 1, 0); PG8_SCHED; PG8_LDA(At, 1, 0); PG8_STAGE(PG8_SA(0, 1), a2 + hstep, voffA);
            PG8_WAIT_L(8); PG8_BAR; PG8_WAIT_L(0); PG8_MMA(0, 0, At, B0); PG8_BAR; PG8_SCHED;
            PG8_LDB(B1, 1, 1); PG8_STAGE(PG8_SB(1, 0), b3, voffB);
            PG8_BAR; PG8_WAIT_L(0); PG8_MMA(0, 1, At, B1); PG8_BAR;
            PG8_LDA(At, 1, 1); PG8_STAGE(PG8_SA(1, 0), a3, voffA);
            PG8_BAR; PG8_WAIT_L(0); PG8_MMA(1, 0, At, B0); PG8_BAR; PG8_SCHED;
            PG8_STAGE(PG8_SB(1, 1), b3 + hstep, voffB);
            PG8_WAIT_V(6); PG8_BAR; PG8_MMA(1, 1, At, B1); PG8_BAR;
            }
        }
        if constexpr (ALIGN_EPI) { if (wr == 0) PG8_BAR; }
        if constexpr (!Epi::AFTER_DRAIN) { E(acc, cur, wr, wc, fr, fq); S.done(cur); }
        if (!has_next) break;
#pragma unroll
        for (int a = 0; a < 2; ++a)
#pragma unroll
            for (int b = 0; b < 2; ++b)
#pragma unroll
                for (int m = 0; m < 4; ++m)
#pragma unroll
                    for (int n = 0; n < 2; ++n) acc[a][b][m][n] = (f32x4){0.f, 0.f, 0.f, 0.f};
        cur = nxt; cA = nA; cB = nB; ++ui;
        if constexpr (ALIGN_EPI) { if (wr == 1) PG8_BAR; }
    }
    PG8_WAIT_V(0);
    if constexpr (!ALIGN_EPI) { if (wr == 0) PG8_BAR; }
    PG8_BAR;
    if constexpr (Epi::AFTER_DRAIN) { E.fused(acc, cur, wr, wc, fr, fq, lds, wid, lane); S.done(cur); }
#undef PG8_SA
#undef PG8_SB
#undef PG8_STAGE
#undef PG8_LDA
#undef PG8_LDB
#undef PG8_MMA
#undef PG8_WAIT_V
#undef PG8_WAIT_L
#undef PG8_BAR
#undef PG8_SCHED
}
}
#define XB_TMO      128
#define XB_XCNT(j)  (256  + 64 * (j))
#define XB_XSUB(j)  (1280 + 64 * (j))
#define XB_XGEN(j)  (2304 + 64 * (j))
#define XB_TOP      3328
#define XB_TOPGEN   3392
#define XCD_BAR_WORDS 3456
#define XB_SPIN_CAP (1u << 18)
#define LAS __attribute__((address_space(3)))

__device__ __forceinline__ unsigned xb_ld(unsigned* p)              { return __hip_atomic_load(p, __ATOMIC_RELAXED, __HIP_MEMORY_SCOPE_AGENT); }
__device__ __forceinline__ unsigned xb_add(unsigned* p, unsigned v) { return __hip_atomic_fetch_add(p, v, __ATOMIC_RELAXED, __HIP_MEMORY_SCOPE_AGENT); }
__device__ __forceinline__ unsigned xb_xcc_id() { return (unsigned)__builtin_amdgcn_s_getreg((3 << 11) | 20) & 0xFu; }
#define XB_SPIN(cond, bar) do { unsigned _sp = 0; while (cond) { __builtin_amdgcn_s_sleep(1); \
    if ((++_sp & 255u) == 0u) { if (xb_ld(&(bar)[XB_TMO])) break; if (_sp > XB_SPIN_CAP) { atomicAdd(&(bar)[XB_TMO], 1u); break; } } } } while (0)

struct XcdBarrier {
    unsigned* bar; unsigned x;
    volatile LAS unsigned* st;
};

__device__ __forceinline__ XcdBarrier xcd_barrier_post(unsigned* bar, volatile LAS unsigned* st) {
    XcdBarrier b; b.bar = bar; b.x = xb_xcc_id(); b.st = st;
    if (threadIdx.x == 0) (void)xb_add(&bar[XB_XCNT(b.x)], 1u);
    return b;
}
__device__ __forceinline__ void xcd_barrier_complete(unsigned* bar, unsigned x, unsigned& nloc, unsigned& nx) {
    const unsigned G = gridDim.x * gridDim.y * gridDim.z;
    unsigned sum, cnt, mine, sp = 0u;
    for (;;) {
        sum = 0u; cnt = 0u; mine = 0u;
#pragma unroll
        for (unsigned j = 0; j < 16; ++j) { const unsigned c = xb_ld(&bar[XB_XCNT(j)]); sum += c; cnt += (c > 0u) ? 1u : 0u; mine = (j == x) ? c : mine; }
        if (sum == G) break;
        __builtin_amdgcn_s_sleep(1);
        if ((++sp & 255u) == 0u) { if (xb_ld(&bar[XB_TMO])) break; if (sp > XB_SPIN_CAP) { atomicAdd(&bar[XB_TMO], 1u); break; } }
    }
    nloc = mine > 0u ? mine : 1u; nx = cnt > 0u ? cnt : 1u;
}

__device__ __forceinline__ void xcd_barrier(const XcdBarrier& b) {
    asm volatile("s_waitcnt vmcnt(0)" ::: "memory");
    __syncthreads();
    if (threadIdx.x == 0) {
        unsigned* bar = b.bar;
        __builtin_amdgcn_s_waitcnt(0);
        unsigned nloc = b.st[0], nx = b.st[1];
        if (nloc == 0u) { xcd_barrier_complete(bar, b.x, nloc, nx); b.st[0] = nloc; b.st[1] = nx; }
        const unsigned old = xb_add(&bar[XB_XSUB(b.x)], 1u);
        const unsigned gen = old / nloc;
        if (old + 1u == (gen + 1u) * nloc) {
            __builtin_amdgcn_fence(__ATOMIC_RELEASE, "agent");
            asm volatile("s_waitcnt vmcnt(0)" ::: "memory");
            const unsigned og = xb_add(&bar[XB_TOP], 1u);
            const unsigned tg = og / nx;
            if (og + 1u == (tg + 1u) * nx) xb_add(&bar[XB_TOPGEN], 1u);
            else XB_SPIN(xb_ld(&bar[XB_TOPGEN]) == tg, bar);
            __builtin_amdgcn_fence(__ATOMIC_ACQUIRE, "agent");
            xb_add(&bar[XB_XGEN(b.x)], 1u);
            asm volatile("s_waitcnt vmcnt(0)" ::: "memory");
        } else {
            XB_SPIN(xb_ld(&bar[XB_XGEN(b.x)]) == gen, bar);
            __builtin_amdgcn_fence(__ATOMIC_ACQUIRE, "agent");
            asm volatile("s_waitcnt vmcnt(0)" ::: "memory");
        }
    }
    __syncthreads();
}
#define GAS __attribute__((address_space(1)))
typedef unsigned short bf16;
typedef float v4f __attribute__((ext_vector_type(4)));
typedef float v2f __attribute__((ext_vector_type(2)));
typedef float v16f __attribute__((ext_vector_type(16)));
typedef short b8 __attribute__((ext_vector_type(8)));
typedef unsigned v4u __attribute__((ext_vector_type(4)));
typedef unsigned v2u __attribute__((ext_vector_type(2)));
#define LDS_WAIT() asm volatile("s_waitcnt lgkmcnt(0)" ::: "memory")
#define MFMA32(a, b, c) __builtin_amdgcn_mfma_f32_32x32x16_bf16((a), (b), (c), 0, 0, 0)
#define MFMA16(a, b, c) __builtin_amdgcn_mfma_f32_16x16x32_bf16((a), (b), (c), 0, 0, 0)

using pg8::MODW;
constexpr int NWAVES = 8, NTHR = 512;
constexpr int D = 2048, DFF = 5632, ML = 8192, MC = 512, MT = 8704;
constexpr float RMS_EPS = 1e-6f;
#ifndef MK_ONE_LAUNCH
#define MK_ONE_LAUNCH 1
#endif
constexpr int NPHASES = 42;
#ifndef KSPLIT
#define KSPLIT 16
#endif
#ifndef PROBE_GU
#define PROBE_GU 0
#endif
#ifndef PROBE_DOWN
#define PROBE_DOWN 0
#endif
#ifndef PROBE_P0
#define PROBE_P0 0
#endif
#ifndef PROBE_ATTN
#define PROBE_ATTN 0
#endif
#ifndef PROBE_SCAN
#define PROBE_SCAN 0
#endif
#ifndef PROBE_SPAT
#define PROBE_SPAT 0
#endif
#ifndef PROBE_NORM
#define PROBE_NORM 0
#endif
#ifndef PROBE_BAR
#define PROBE_BAR 0
#endif
#ifndef NO_ATTN
#define NO_ATTN 0
#endif
#ifndef NO_SCAN
#define NO_SCAN 0
#endif
#ifndef NO_SPAT
#define NO_SPAT 0
#endif
#ifndef NO_P0
#define NO_P0 0
#endif

constexpr size_t MiB = 1u << 20;
constexpr size_t WS_CTL = 0;
constexpr size_t WS_VSS = 1 * MiB;
constexpr size_t WS_QKSS = 1 * MiB + 128 * 1024;
constexpr size_t WS_MOD = 3 * MiB;
constexpr size_t ZERO_BYTES = 4 * MiB;
constexpr size_t WS_HC = 4 * MiB;
constexpr size_t WS_XN = 8 * MiB;
constexpr size_t WS_ACT = 42 * MiB;
constexpr size_t WS_Y = 144 * MiB;
constexpr size_t WS_SLAB = 913 * MiB;
constexpr size_t WS_WGU = 280 * MiB, WS_WDN = 632 * MiB, WS_AWIN = 808 * MiB, WS_AWOUT = 840 * MiB, WS_AWS = 856 * MiB;
constexpr size_t WS_BQKV = 857 * MiB, WS_BWO = 881 * MiB, WS_CWIN = 889 * MiB, WS_CGLU = 897 * MiB, WS_END = 977 * MiB;
constexpr int CW_BAR = 4096, BAR_STRIDE = 3584;
static_assert((CW_BAR + 48 * BAR_STRIDE) * 4 <= (int)MiB, "ctl");
constexpr int LDS_BYTES = 147456;
constexpr int MISC_OFF = 131072 + 320;

__device__ __forceinline__ float bf2f(unsigned short b) { return __uint_as_float(((unsigned)b) << 16); }
__device__ __forceinline__ unsigned pk_bf16(float lo, float hi) { return pg8::cvt_pk_bf16(lo, hi); }
__device__ __forceinline__ unsigned pk_bf16_m(float lo, float hi) { unsigned r; asm volatile("v_cvt_pk_bf16_f32 %0, %1, %2\n\ts_nop 1" : "=v"(r) : "v"(lo), "v"(hi)); return r; }
__device__ __forceinline__ float wave_sum(float v) {
#pragma unroll
    for (int o = 1; o < 64; o <<= 1) v += __shfl_xor(v, o);
    return v;
}

#define OPAQUE_V(x) asm volatile("" : "+v"(x))
struct Args { const float* in[29]; float* out; unsigned char* ws; int ph_lo, ph_hi, li, pad; };

__device__ __forceinline__ void tr_item(const float* W, int K, int N, bf16* WT, int nh, int item, LAS float* scr, int lane) {
    const int nblk = N / 32, kb = item / nblk, nb = item - kb * nblk, k0 = 64 * kb, n0 = 32 * nb;
    int drow0 = n0; if (nh) { const int half = n0 >= nh ? 1 : 0, c = n0 - half * nh; drow0 = 256 * (c >> 7) + 128 * half + (c & 127); }
    const float* src = W + (size_t)k0 * N + n0 + (lane & 31) + (size_t)(lane >> 5) * N;
#pragma unroll 8
    for (int i = 0; i < 32; ++i) scr[(2 * i + (lane >> 5)) * 33 + (lane & 31)] = src[(size_t)(2 * i) * N];
    LDS_WAIT(); asm volatile("" ::: "memory");
    const int c = lane & 7;
#pragma unroll
    for (int j = 0; j < 4; ++j) { const int n = (lane >> 3) + 8 * j; const LAS float* s = scr + (8 * c) * 33 + n;
        v4u o; o.x = pk_bf16(s[0 * 33], s[1 * 33]); o.y = pk_bf16(s[2 * 33], s[3 * 33]); o.z = pk_bf16(s[4 * 33], s[5 * 33]); o.w = pk_bf16(s[6 * 33], s[7 * 33]);
        *(v4u*)(WT + (size_t)(drow0 + n) * K + k0 + 8 * c) = o; }
    LDS_WAIT(); asm volatile("" ::: "memory");
}
__device__ __forceinline__ void p0_prologue(const Args& a, LAS unsigned char* lds, int gw, int NGW, int tid, int lane, int wave, int it0) {
    OPAQUE_V(tid); OPAQUE_V(lane);
    LAS float* sl = (LAS float*)(lds + 73728);
    for (int i = tid; i < 3 * 2048; i += NTHR) { const float v = i < 4096 ? a.in[1][i] : a.in[3][i - 4096]; sl[i] = v / (1.0f + __expf(-v)); }
    __syncthreads();
    LAS float* scr = (LAS float*)(lds + wave * 8704);
    unsigned char* ws = a.ws;
    constexpr int I_ADA = 4 * 72 * 16, I_GU = 32 * 352, I_DN = 88 * 64, I_AIN = 32 * 128, I_SQ = 32 * 64, I_QKV = 32 * 192, I_WS = 256, I_HC = 256;
    constexpr int NITEMS = I_ADA + 8 * I_GU + 8 * I_DN + 2 * I_AIN + 2 * I_SQ + I_QKV + I_SQ + I_SQ + I_AIN + I_WS + I_HC;
    for (int it = gw + it0; it < NITEMS; it += NGW) {
        int r = it;
        if (r < I_ADA) {
            const int layer = r / 1152, rr = r - layer * 1152, cb = rr >> 4, ks = rr & 15, n0 = cb * 256 + lane * 4, k0 = ks * 128;
            const float* Wp = a.in[4] + (size_t)layer * 2048 * MODW + (size_t)k0 * MODW + n0;
            v4f a0 = {0.f, 0.f, 0.f, 0.f}, a1 = a0, a2 = a0;
#pragma unroll 8
            for (int k = 0; k < 128; ++k) { const v4f w = *(const v4f*)(Wp + (size_t)k * MODW); a0 += w * sl[k0 + k]; a1 += w * sl[2048 + k0 + k]; a2 += w * sl[4096 + k0 + k]; }
            if (ks == 0) { const v4f bv = *(const v4f*)(a.in[5] + (size_t)layer * MODW + n0); a0 += bv; a1 += bv; a2 += bv; }
            float* mp = (float*)(ws + WS_MOD) + (size_t)layer * 3 * MODW + n0;
#pragma unroll
            for (int j = 0; j < 4; ++j) { unsafeAtomicAdd(mp + j, a0[j]); unsafeAtomicAdd(mp + MODW + j, a1[j]); unsafeAtomicAdd(mp + 2 * MODW + j, a2[j]); }
            continue; }
        r -= I_ADA;
        if (r < 8 * I_GU) { const int f = r / I_GU; tr_item(a.in[7] + (size_t)f * 2048 * 11264, 2048, 11264, (bf16*)(ws + WS_WGU) + (size_t)f * 11264 * 2048, 5632, r - f * I_GU, scr, lane); continue; } r -= 8 * I_GU;
        if (r < 8 * I_DN) { const int f = r / I_DN; tr_item(a.in[8] + (size_t)f * 5632 * 2048, 5632, 2048, (bf16*)(ws + WS_WDN) + (size_t)f * 2048 * 5632, 0, r - f * I_DN, scr, lane); continue; } r -= 8 * I_DN;
        if (r < 2 * I_AIN) { const int j = r / I_AIN; tr_item(a.in[9] + (size_t)j * 2048 * 4096, 2048, 4096, (bf16*)(ws + WS_AWIN) + (size_t)j * 4096 * 2048, 0, r - j * I_AIN, scr, lane); continue; } r -= 2 * I_AIN;
        if (r < 2 * I_SQ) { const int j = r / I_SQ; tr_item(a.in[13] + (size_t)j * 2048 * 2048, 2048, 2048, (bf16*)(ws + WS_AWOUT) + (size_t)j * 2048 * 2048, 0, r - j * I_SQ, scr, lane); continue; } r -= 2 * I_SQ;
        if (r < I_QKV) { tr_item(a.in[14], 2048, 6144, (bf16*)(ws + WS_BQKV), 0, r, scr, lane); continue; } r -= I_QKV;
        if (r < I_SQ) { tr_item(a.in[18], 2048, 2048, (bf16*)(ws + WS_BWO), 0, r, scr, lane); continue; } r -= I_SQ;
        if (r < I_SQ) { tr_item(a.in[19], 2048, 2048, (bf16*)(ws + WS_CWIN), 0, r, scr, lane); continue; } r -= I_SQ;
        if (r < I_AIN) { tr_item(a.in[28], 2048, 4096, (bf16*)(ws + WS_CGLU), 2048, r, scr, lane); continue; } r -= I_AIN;
        if (r >= I_WS) { r -= I_WS; const v4f* s = (const v4f*)(a.in[2] + (size_t)r * 4096) + lane; v4f* d = (v4f*)((float*)(ws + WS_HC) + (size_t)r * 4096) + lane;
#pragma unroll
          for (int j = 0; j < 16; ++j) d[64 * j] = s[64 * j];
          continue; }
        { const float* s = a.in[11] + (size_t)r * 2048 + lane * 4; bf16* d = (bf16*)(ws + WS_AWS) + (size_t)r * 2048 + lane * 4;
#pragma unroll
          for (int j = 0; j < 8; ++j) { const v4f v = *(const v4f*)(s + 256 * j); v2u o; o.x = pk_bf16(v[0], v[1]); o.y = pk_bf16(v[2], v[3]); *(v2u*)(d + 256 * j) = o; } }
    }
}

__device__ __forceinline__ void ctx_rows(float* hctx, const float* slab, const float* gain, const float* modl, int s, bf16* xn, LAS unsigned char* lds, int blk, int G, int tid, int lane, int wave) {
    LAS float* red = (LAS float*)(lds + 131072 + 1024);
    const v4f* sh = (const v4f*)(modl + 2 * MODW + (3 * s) * D) + tid; const v4f* sc = sh + D / 4; const v4f gn = ((const v4f*)gain)[tid];
    for (int cr = blk; cr < MC; cr += G) {
        v4f* xr = (v4f*)(hctx + (size_t)cr * D) + tid;
        v4f v = *xr;
        if (slab) { v4f pv[KSPLIT];
#pragma unroll
            for (int sl = 0; sl < KSPLIT; ++sl) pv[sl] = ((const v4f*)(slab + ((size_t)sl * MC + cr) * D))[tid];
#pragma unroll
            for (int sl = 0; sl < KSPLIT; ++sl) v += pv[sl];
            *xr = v; }
        const float ss = wave_sum((v[0] * v[0] + v[1] * v[1]) + (v[2] * v[2] + v[3] * v[3]));
        __syncthreads();
        if (lane == 0) red[wave] = ss;
        __syncthreads();
        float tot = 0.f;
#pragma unroll
        for (int w = 0; w < NWAVES; ++w) tot += red[w];
        const float r = rsqrtf(tot * (1.0f / D) + RMS_EPS);
        const v4f y = v * r * gn * (*sc + 1.0f) + *sh; v2u w2; w2.x = pk_bf16(y[0], y[1]); w2.y = pk_bf16(y[2], y[3]);
        ((v2u*)(xn + (size_t)(ML + cr) * D))[tid] = w2;
    }
}
__device__ __forceinline__ void norm_phase(const float* hlat, float* hctx, const float* slab, const float* gain, const float* modl, int s, bf16* xn, int M, LAS unsigned char* lds, int blk, int G, int gw, int NGW, int tid, int lane, int wave) {
    OPAQUE_V(lane); OPAQUE_V(tid);
    for (int row = gw; row < ML; row += NGW) {
        const int cls = row >> 12;
        const v4f* xr = (const v4f*)(hlat + (size_t)row * D) + lane;
        const v4f* sh = (const v4f*)(modl + cls * MODW + (3 * s) * D) + lane; const v4f* sc = sh + D / 4; const v4f* gn = (const v4f*)gain + lane;
        v4f v[8]; float ss = 0.f;
#pragma unroll
        for (int j = 0; j < 8; ++j) { v[j] = xr[64 * j]; ss += (v[j][0] * v[j][0] + v[j][1] * v[j][1]) + (v[j][2] * v[j][2] + v[j][3] * v[j][3]); }
        const float r = rsqrtf(wave_sum(ss) * (1.0f / D) + RMS_EPS);
        v2u* o = (v2u*)(xn + (size_t)row * D) + lane;
#pragma unroll
        for (int j = 0; j < 8; ++j) { const v4f y = v[j] * r * gn[64 * j] * (sc[64 * j] + 1.0f) + sh[64 * j]; v2u w; w.x = pk_bf16(y[0], y[1]); w.y = pk_bf16(y[2], y[3]); o[64 * j] = w; }
    }
    if (M > ML) ctx_rows(hctx, slab, gain, modl, s, xn, lds, blk, G, tid, lane, wave);
}

__device__ __forceinline__ void spatial_phase(const bf16* uv, const float* vss, const bf16* wsb, const float* vgain, const float* bsg, bf16* su, int nchunk,
                                              LAS unsigned char* lds, int gw, int NGW, int lane, int wave) {
    OPAQUE_V(lane);
    LAS float* rq = (LAS float*)(lds + wave * 512);
    const int h = lane >> 5, r32 = lane & 31;
    for (int item = gw; item < nchunk * 64; item += NGW) {
        const int cb = item & 3, g = (item >> 2) & 15, ch = item >> 6, row0 = ch * 128;
        rq[lane] = rsqrtf(vss[row0 + lane] * (1.0f / D) + RMS_EPS); rq[64 + lane] = rsqrtf(vss[row0 + 64 + lane] * (1.0f / D) + RMS_EPS);
        const bf16* vp = uv + (size_t)row0 * 4096 + 2048 + 128 * g + 32 * cb + r32 + (size_t)(8 * h) * 4096;
        unsigned short raw[64];
#pragma unroll
        for (int s = 0; s < 8; ++s)
#pragma unroll
            for (int j = 0; j < 8; ++j) raw[8 * s + j] = vp[(size_t)(16 * s + j) * 4096];
        LDS_WAIT(); asm volatile("" ::: "memory");
        b8 Af[8];
#pragma unroll
        for (int s = 0; s < 8; ++s) { const v4f q0 = *(const LAS v4f*)(rq + 16 * s + 8 * h), q1 = *(const LAS v4f*)(rq + 16 * s + 8 * h + 4);
            v4u w; w.x = pk_bf16_m(bf2f(raw[8 * s + 0]) * q0[0], bf2f(raw[8 * s + 1]) * q0[1]); w.y = pk_bf16_m(bf2f(raw[8 * s + 2]) * q0[2], bf2f(raw[8 * s + 3]) * q0[3]);
            w.z = pk_bf16_m(bf2f(raw[8 * s + 4]) * q1[0], bf2f(raw[8 * s + 5]) * q1[1]); w.w = pk_bf16_m(bf2f(raw[8 * s + 6]) * q1[2], bf2f(raw[8 * s + 7]) * q1[3]); Af[s] = __builtin_bit_cast(b8, w); }
        v16f acc[4];
#pragma unroll
        for (int pb = 0; pb < 4; ++pb) {
#pragma unroll
            for (int i = 0; i < 16; ++i) acc[pb][i] = 0.f;
            const bf16* wp = wsb + ((size_t)g * 128 + 32 * pb + r32) * 128 + 8 * h;
#pragma unroll
            for (int s = 0; s < 8; ++s) { const b8 Bf = *(const b8*)(wp + 16 * s); acc[pb] = MFMA32(Af[s], Bf, acc[pb]); } }
#pragma unroll
        for (int pb = 0; pb < 4; ++pb) { const int p = 32 * pb + r32; const float bsp = bsg[g * 128 + p]; const size_t row = (size_t)(row0 + p);
#pragma unroll
            for (int i4 = 0; i4 < 4; ++i4) { const int cc = 128 * g + 32 * cb + 8 * i4 + 4 * h; const v4f vg = *(const v4f*)(vgain + cc);
                const v2u uu = *(const v2u*)(uv + row * 4096 + cc);
                const float u0 = __uint_as_float(uu.x << 16), u1 = __uint_as_float(uu.x & 0xffff0000u), u2 = __uint_as_float(uu.y << 16), u3 = __uint_as_float(uu.y & 0xffff0000u);
                v2u w; w.x = pk_bf16(u0 * (acc[pb][4 * i4 + 0] * vg[0] + bsp), u1 * (acc[pb][4 * i4 + 1] * vg[1] + bsp)); w.y = pk_bf16(u2 * (acc[pb][4 * i4 + 2] * vg[2] + bsp), u3 * (acc[pb][4 * i4 + 3] * vg[3] + bsp));
                *(v2u*)(su + row * D + cc) = w; } }
    }
}

typedef short s16x4 __attribute__((ext_vector_type(4)));
__device__ __forceinline__ void attn_phase(const bf16* qkv, const float* qkss, const float* qgain, const float* kgain, const float* rpb, bf16* o, LAS unsigned char* lds, int vcu, int G, int tid, int lane, int wave) {
    OPAQUE_V(lane); OPAQUE_V(tid);
    const int h = lane >> 5, r32 = lane & 31, i16 = lane & 15, blk16 = (lane >> 4) & 1, tq = i16 >> 2, tp = i16 & 3;
    constexpr int KP = 272, VP = 288, STAGE = 32 * KP + 32 * VP, BIAS_OFF = 2 * STAGE;
    constexpr int NG_LAT = 2 * 16 * 16, NG_CTX = 32;
    const int skey = tid >> 4, schunk = tid & 15;
    LAS float* biasl = (LAS float*)(lds + BIAS_OFF);
    for (int grp = vcu; grp < NG_LAT + NG_CTX; grp += G) {
        const bool lat = grp < NG_LAT;
        int b, hd, r0 = 0;
        if (lat) { r0 = (grp & 15) * 4; hd = (grp >> 4) & 15; b = grp >> 8; } else { const int w = grp - NG_LAT; hd = w & 15; b = w >> 4; }
        int qrow, r = 0, qh = 0, rstart = 0, gr0 = 0, nwin = 0;
        if (lat) { r = r0 + (wave >> 1); qh = wave & 1; qrow = b * 4096 + r * 64 + 32 * qh + r32; rstart = r - 4 < 0 ? 0 : (r - 4 > 56 ? 56 : r - 4);
            gr0 = r0 - 4 < 0 ? 0 : (r0 - 4 > 56 ? 56 : r0 - 4); const int gl = r0 - 1 < 0 ? 0 : (r0 - 1 > 56 ? 56 : r0 - 1); nwin = 2 * (gl + 7 - gr0 + 1); }
        else qrow = ML + b * 256 + 32 * wave + r32;
        const int nt = nwin + 8;
        if (tid < 465) biasl[tid] = rpb[hd * 465 + tid];
        const float rqv = rsqrtf(qkss[(size_t)hd * MT + qrow] * (1.0f / 128.0f) + RMS_EPS) * 0.08838834764831845f;
        const bf16* qp = qkv + (size_t)qrow * 6144 + 128 * hd + 8 * h;
        b8 Qf[8];
#pragma unroll
        for (int s = 0; s < 8; ++s) { const v4u raw = *(const v4u*)(qp + 16 * s); const int d0 = 16 * s + 8 * h;
            const v4f g0 = *(const v4f*)(qgain + d0), g1 = *(const v4f*)(qgain + d0 + 4), k0 = *(const v4f*)(kgain + d0), k1 = *(const v4f*)(kgain + d0 + 4);
            v4u w;
            w.x = pk_bf16_m(__uint_as_float(raw.x << 16) * rqv * g0[0] * k0[0], __uint_as_float(raw.x & 0xffff0000u) * rqv * g0[1] * k0[1]);
            w.y = pk_bf16_m(__uint_as_float(raw.y << 16) * rqv * g0[2] * k0[2], __uint_as_float(raw.y & 0xffff0000u) * rqv * g0[3] * k0[3]);
            w.z = pk_bf16_m(__uint_as_float(raw.z << 16) * rqv * g1[0] * k1[0], __uint_as_float(raw.z & 0xffff0000u) * rqv * g1[1] * k1[1]);
            w.w = pk_bf16_m(__uint_as_float(raw.w << 16) * rqv * g1[2] * k1[2], __uint_as_float(raw.w & 0xffff0000u) * rqv * g1[3] * k1[3]);
            Qf[s] = __builtin_bit_cast(b8, w); }
        v16f Oacc[4];
#pragma unroll
        for (int db = 0; db < 4; ++db)
#pragma unroll
            for (int i = 0; i < 16; ++i) Oacc[db][i] = 0.f;
        float lsum = 0.f;
        const int qc = 32 * qh + r32, cstart = qc - 8 < 0 ? 0 : (qc - 8 > 48 ? 48 : qc - 8);
        v4u kreg, vreg; float rkreg;
#define ATT_KROW0(t) ((t) < nwin ? b * 4096 + 64 * gr0 + 32 * (t) : ML + b * 256 + 32 * ((t) - nwin))
#define ATT_LOAD(t) do { const size_t gro_ = (size_t)(ATT_KROW0(t) + skey); kreg = *(const v4u*)(qkv + gro_ * 6144 + 2048 + 128 * hd + 8 * schunk); vreg = *(const v4u*)(qkv + gro_ * 6144 + 4096 + 128 * hd + 8 * schunk); \
            rkreg = qkss[(size_t)(16 + hd) * MT + gro_]; } while (0)
#define ATT_STORE(buf) do { const float rk_ = rsqrtf(rkreg * (1.0f / 128.0f) + RMS_EPS); v4u kw_; \
            kw_.x = pk_bf16(__uint_as_float(kreg.x << 16) * rk_, __uint_as_float(kreg.x & 0xffff0000u) * rk_); kw_.y = pk_bf16(__uint_as_float(kreg.y << 16) * rk_, __uint_as_float(kreg.y & 0xffff0000u) * rk_); \
            kw_.z = pk_bf16(__uint_as_float(kreg.z << 16) * rk_, __uint_as_float(kreg.z & 0xffff0000u) * rk_); kw_.w = pk_bf16(__uint_as_float(kreg.w << 16) * rk_, __uint_as_float(kreg.w & 0xffff0000u) * rk_); \
            *(LAS v4u*)(lds + (buf) * STAGE + skey * KP + schunk * 16) = kw_; *(LAS v4u*)(lds + (buf) * STAGE + 32 * KP + skey * VP + schunk * 16) = vreg; } while (0)
        ATT_LOAD(0); ATT_STORE(0);
        __syncthreads();
        for (int t = 0; t < nt; ++t) {
            if (t + 1 < nt) ATT_LOAD(t + 1);
            const bool win = t < nwin; const int gr = gr0 + (t >> 1);
            if (!win || (gr >= rstart && gr < rstart + 8)) {
                LAS unsigned char* Kl = lds + (t & 1) * STAGE; LAS unsigned char* Vl = Kl + 32 * KP;
                v16f sacc;
#pragma unroll
                for (int i = 0; i < 16; ++i) sacc[i] = 0.f;
#pragma unroll
                for (int s = 0; s < 8; ++s) { const b8 Kf = *(const LAS b8*)(Kl + r32 * KP + (16 * s + 8 * h) * 2); sacc = MFMA32(Kf, Qf[s], sacc); }
                float p[16];
                if (win) { const LAS float* bp = biasl + (gr - r + 7) * 31 + 15 - qc + 32 * (t & 1);
#pragma unroll
                    for (int i = 0; i < 16; ++i) { const int key = (i & 3) + 8 * (i >> 2) + 4 * h, kc = 32 * (t & 1) + key; const bool valid = (unsigned)(kc - cstart) < 16u;
                        const float pv = valid ? __expf(sacc[i] + bp[valid ? key : 0]) : 0.f; p[i] = pv; lsum += pv; } }
                else {
#pragma unroll
                    for (int i = 0; i < 16; ++i) { const float pv = __expf(sacc[i]); p[i] = pv; lsum += pv; } }
#pragma unroll
                for (int s2 = 0; s2 < 2; ++s2) {
                    v4u pw; pw.x = pk_bf16_m(p[8 * s2 + 0], p[8 * s2 + 1]); pw.y = pk_bf16_m(p[8 * s2 + 2], p[8 * s2 + 3]); pw.z = pk_bf16_m(p[8 * s2 + 4], p[8 * s2 + 5]); pw.w = pk_bf16_m(p[8 * s2 + 6], p[8 * s2 + 7]);
                    const b8 Pf = __builtin_bit_cast(b8, pw);
                    const LAS unsigned char* vb = Vl + (16 * s2 + 4 * h + tq) * VP + (16 * blk16 + 4 * tp) * 2;
#pragma unroll
                    for (int db = 0; db < 4; ++db) {
                        const s16x4 lo = __builtin_amdgcn_ds_read_tr16_b64_v4i16((LAS s16x4*)(vb + 64 * db)), hi = __builtin_amdgcn_ds_read_tr16_b64_v4i16((LAS s16x4*)(vb + 8 * VP + 64 * db));
                        const b8 Vf = __builtin_shufflevector(lo, hi, 0, 1, 2, 3, 4, 5, 6, 7);
                        Oacc[db] = MFMA32(Vf, Pf, Oacc[db]); } }
            }
            if (t + 1 < nt) ATT_STORE((t + 1) & 1);
            __syncthreads();
        }
#undef ATT_KROW0
#undef ATT_LOAD
#undef ATT_STORE
        lsum += __shfl_xor(lsum, 32);
        const float inv = 1.0f / lsum;
        bf16* op = o + (size_t)qrow * D + 128 * hd + 4 * h;
#pragma unroll
        for (int db = 0; db < 4; ++db)
#pragma unroll
            for (int i4 = 0; i4 < 4; ++i4) { v2u w; w.x = pk_bf16(Oacc[db][4 * i4 + 0] * inv, Oacc[db][4 * i4 + 1] * inv); w.y = pk_bf16(Oacc[db][4 * i4 + 2] * inv, Oacc[db][4 * i4 + 3] * inv);
                *(v2u*)(op + 32 * db + 8 * i4) = w; }
    }
}

__device__ __forceinline__ void scan_phase(const bf16* ub, const float* a_re, const float* a_im, const float* log_dt, const float* b_re, const float* b_im, const float* c_re, const float* c_im,
                                           float* ybuf, LAS unsigned char* lds, int blk, int G, int wave, int lane) {
    OPAQUE_V(lane);
    if (wave >= 2) return;
    LAS float* BU = (LAS float*)(lds + wave * 32768);
    LAS unsigned char* HS = lds + wave * 32768 + 16384;
    LAS unsigned short* BB = (LAS unsigned short*)(lds + wave * 32768 + 16384 + 8704);
    const int h = lane >> 5, r32 = lane & 31, p = lane, ch = lane & 15, l4 = lane >> 4;
    for (int chain = blk * 2 + wave; chain < 512; chain += 2 * G) {
        const int dir = chain & 1, g = (chain >> 1) & 127, b = chain >> 8, dg = dir * 128 + g;
        const float lr = a_re[(size_t)dg * 64 + p], li = a_im[(size_t)dg * 64 + p], dt = expf(log_dt[dg]);
        const float er = expf(lr * dt), ar = er * cosf(li * dt), ai = er * sinf(li * dt);
        { const float nr = ar - 1.0f, ni = ai, den = 1.0f / (lr * lr + li * li), cr = (nr * lr + ni * li) * den, ci = (ni * lr - nr * li) * den;
          const float* brp = b_re + ((size_t)dg * 64 + p) * 16; const float* bip = b_im + ((size_t)dg * 64 + p) * 16;
#pragma unroll
          for (int c4 = 0; c4 < 4; ++c4) { const v4f br = *(const v4f*)(brp + 4 * c4), bi = *(const v4f*)(bip + 4 * c4);
              v2u wr_, wi_; wr_.x = pk_bf16(cr * br[0] - ci * bi[0], cr * br[1] - ci * bi[1]); wr_.y = pk_bf16(cr * br[2] - ci * bi[2], cr * br[3] - ci * bi[3]);
              wi_.x = pk_bf16(cr * bi[0] + ci * br[0], cr * bi[1] + ci * br[1]); wi_.y = pk_bf16(cr * bi[2] + ci * br[2], cr * bi[3] + ci * br[3]);
              *(LAS v2u*)(BB + (p * 2 + 0) * 16 + 4 * c4) = wr_; *(LAS v2u*)(BB + (p * 2 + 1) * 16 + 4 * c4) = wi_; } }
        LDS_WAIT(); asm volatile("" ::: "memory");
        b8 Bf[4];
#pragma unroll
        for (int cb = 0; cb < 4; ++cb) Bf[cb] = *(const LAS b8*)(BB + ((16 * cb + (r32 >> 1)) * 2 + (r32 & 1)) * 16 + 8 * h);
        b8 Cf[4];
#pragma unroll
        for (int ks = 0; ks < 4; ++ks) { const v4f cre = *(const v4f*)(c_re + ((size_t)dg * 16 + ch) * 64 + 16 * ks + 4 * l4), cim = *(const v4f*)(c_im + ((size_t)dg * 16 + ch) * 64 + 16 * ks + 4 * l4);
            v4u w; w.x = pk_bf16_m(cre[0], -cim[0]); w.y = pk_bf16_m(cre[1], -cim[1]); w.z = pk_bf16_m(cre[2], -cim[2]); w.w = pk_bf16_m(cre[3], -cim[3]); Cf[ks] = __builtin_bit_cast(b8, w); }
        float hr = 0.f, hi = 0.f;
        for (int bi_ = 0; bi_ < 136; ++bi_) {
            int rb, sg;
            if (dir == 0) { rb = bi_ < 8 ? ML + b * 256 + 32 * bi_ : b * 4096 + 32 * (bi_ - 8); sg = 1; }
            else { rb = bi_ < 8 ? ML + b * 256 + 255 - 32 * bi_ : b * 4096 + 4095 - 32 * (bi_ - 8); sg = -1; }
            const b8 Uf = *(const b8*)(ub + (size_t)(rb + sg * r32) * D + 16 * g + 8 * h);
#pragma unroll
            for (int cb = 0; cb < 4; ++cb) { v16f z;
#pragma unroll
                for (int i = 0; i < 16; ++i) z[i] = 0.f;
                const v16f dacc = MFMA32(Uf, Bf[cb], z);
#pragma unroll
                for (int i = 0; i < 16; ++i) BU[((i & 3) + 8 * (i >> 2) + 4 * h) * 128 + 32 * cb + r32] = dacc[i]; }
            LDS_WAIT(); asm volatile("" ::: "memory");
            v2f bu[32];
#pragma unroll
            for (int i = 0; i < 32; ++i) bu[i] = *(const LAS v2f*)(BU + i * 128 + 2 * p);
#pragma unroll
            for (int i = 0; i < 32; ++i) { const float nr = ar * hr - ai * hi + bu[i][0], ni = ar * hi + ai * hr + bu[i][1]; hr = nr; hi = ni;
                *(LAS unsigned*)(HS + i * 272 + 4 * p) = pk_bf16(hr, hi); }
            LDS_WAIT(); asm volatile("" ::: "memory");
#pragma unroll
            for (int tb = 0; tb < 2; ++tb) { v4f ya = {0.f, 0.f, 0.f, 0.f};
#pragma unroll
                for (int ks = 0; ks < 4; ++ks) { const b8 Hf = *(const LAS b8*)(HS + (16 * tb + ch) * 272 + (32 * ks + 8 * l4) * 2); ya = MFMA16(Cf[ks], Hf, ya); }
                const int row = rb + sg * (16 * tb + ch);
                *(v4f*)(ybuf + ((size_t)dir * MT + row) * D + 16 * g + 4 * l4) = ya; }
        }
    }
}
__device__ __forceinline__ void s5post_phase(const bf16* ub, const float* ybuf, const float* cd, bf16* xg, int M, int gw, int NGW, int lane) {
    OPAQUE_V(lane);
    for (int row = gw; row < M; row += NGW) {
        const v2u* up = (const v2u*)(ub + (size_t)row * D) + lane; const v4f* yf = (const v4f*)(ybuf + (size_t)row * D) + lane; const v4f* yr = (const v4f*)(ybuf + ((size_t)MT + row) * D) + lane;
        const v4f* dp = (const v4f*)cd + lane; v2u* o = (v2u*)(xg + (size_t)row * D) + lane;
#pragma unroll
        for (int j = 0; j < 8; ++j) { const v2u uu = up[64 * j]; const v4f d = dp[64 * j], a = yf[64 * j], c = yr[64 * j];
            const float y0 = d[0] * __uint_as_float(uu.x << 16) + a[0] + c[0], y1 = d[1] * __uint_as_float(uu.x & 0xffff0000u) + a[1] + c[1];
            const float y2 = d[2] * __uint_as_float(uu.y << 16) + a[2] + c[2], y3 = d[3] * __uint_as_float(uu.y & 0xffff0000u) + a[3] + c[3];
            v2u w; w.x = pk_bf16(pg8::fgelu(y0), pg8::fgelu(y1)); w.y = pk_bf16(pg8::fgelu(y2), pg8::fgelu(y3)); o[64 * j] = w; }
    }
}

__global__ void __launch_bounds__(NTHR, 2) fwd_kernel(Args a) {
    extern __shared__ __attribute__((aligned(16))) unsigned char lds_raw[];
    LAS unsigned char* lds = (LAS unsigned char*)lds_raw;
    volatile LAS unsigned* MISC = (volatile LAS unsigned*)(lds + MISC_OFF);
    const int tid = threadIdx.x, lane = tid & 63, wave = __builtin_amdgcn_readfirstlane(tid >> 6);
    const int G = gridDim.x, bx = blockIdx.x, vcu = (G % 8 == 0) ? (bx % 8) * (G / 8) + bx / 8 : bx;
    const int gw = vcu * NWAVES + wave, NGW = G * NWAVES;
    for (int u = tid; u < (LDS_BYTES - 131072) / 4; u += NTHR) ((LAS unsigned*)(lds + 131072))[u] = 0u;
    __syncthreads();
    unsigned char* ws = a.ws;
    XcdBarrier bar = xcd_barrier_post((unsigned*)(ws + WS_CTL) + CW_BAR + a.li * BAR_STRIDE, MISC + 8);
    const int lo = a.ph_lo, hi = a.ph_hi;
    int pc = 0;
#define PH_IN (lo <= pc && pc < hi)
#define PH_END() do { if (pc + 1 < hi) { xcd_barrier(bar); for (int pb_ = 0; pb_ < PROBE_BAR; ++pb_) xcd_barrier(bar); } } while (0)
    float* mod = (float*)(ws + WS_MOD); float* hc = (float*)(ws + WS_HC);
    bf16* xn = (bf16*)(ws + WS_XN); bf16* act = (bf16*)(ws + WS_ACT); float* ybuf = (float*)(ws + WS_Y);
    float* vss = (float*)(ws + WS_VSS); float* qkss = (float*)(ws + WS_QKSS); float* slab = (float*)(ws + WS_SLAB);
    bool pend = false;

    if (PH_IN) { p0_prologue(a, lds, gw, NGW, tid, lane, wave, 0); for (int rp = 0; rp < PROBE_P0; ++rp) { xcd_barrier(bar); p0_prologue(a, lds, gw, NGW, tid, lane, wave, 3 * NGW); } PH_END(); } ++pc;

    for (int f = 0; f < 8; ++f) {
        const int layer = f >> 1, sub = f & 1, kind = layer % 3, M = (layer == 3) ? ML : MT;
        const float* modl = mod + (size_t)layer * 3 * MODW;
        const float* hin_l = (f == 0) ? a.in[0] : (const float*)a.out;
        if (PH_IN) { norm_phase(hin_l, hc, pend ? slab : nullptr, a.in[6] + (size_t)(layer * 3 + 2 * sub) * D, modl, 2 * sub, xn, M, lds, bx, G, gw, NGW, tid, lane, wave);
            for (int rp = 0; rp < PROBE_NORM; ++rp) { xcd_barrier(bar); norm_phase(hin_l, hc, nullptr, a.in[6] + (size_t)(layer * 3 + 2 * sub) * D, modl, 2 * sub, xn, M, lds, bx, G, gw, NGW, tid, lane, wave); } PH_END(); } ++pc; pend = false;
        if (PH_IN) { pg8::Gemm g{xn, (const bf16*)(ws + WS_WGU) + (size_t)f * 11264 * 2048, M, 11264, 2048}; pg8::StaticOrder S; S.init(M, 11264, 2048, G, bx);
            pg8::EpiSwiglu E{act, DFF}; for (int rp = 0; rp <= PROBE_GU; ++rp) { if (rp) xcd_barrier(bar); pg8::gemm_phase<pg8::EpiSwiglu, pg8::StaticOrder, true, true>(lds, g, S, E); } PH_END(); } ++pc;
        if (PH_IN) { pg8::Gemm g{act, (const bf16*)(ws + WS_WDN) + (size_t)f * 2048 * 5632, M, 2048, DFF}; pg8::SplitOrder S; S.init(2048, DFF, G, bx, KSPLIT, M > ML);
            pg8::EpiRes E{hin_l, hc, a.out, hc, modl + (6 * sub + 2) * D, slab, 0.5f};
            for (int rp = 0; rp < PROBE_DOWN; ++rp) { pg8::EpiRes E2{hin_l, hc, ybuf, ybuf, modl + (6 * sub + 2) * D, ybuf + 17 * 1024 * 1024, 0.5f}; pg8::gemm_phase<pg8::EpiRes, pg8::SplitOrder, true, true>(lds, g, S, E2); xcd_barrier(bar); }
            pg8::gemm_phase<pg8::EpiRes, pg8::SplitOrder, true, true>(lds, g, S, E); PH_END(); } ++pc; pend = M > ML;
        if (sub == 0) {
            const int j = layer / 3;
            if (PH_IN) { norm_phase(a.out, hc, pend ? slab : nullptr, a.in[6] + (size_t)(layer * 3 + 1) * D, modl, 1, xn, M, lds, bx, G, gw, NGW, tid, lane, wave); PH_END(); } ++pc; pend = false;
            if (kind == 0) {
                if (PH_IN) { pg8::Gemm g{xn, (const bf16*)(ws + WS_AWIN) + (size_t)j * 4096 * 2048, M, 4096, 2048}; pg8::StaticOrder S; S.init(M, 4096, 2048, G, bx);
                    pg8::EpiBf<1> E{act, 4096, vss + (size_t)j * MT}; pg8::gemm_phase<pg8::EpiBf<1>, pg8::StaticOrder, true, true>(lds, g, S, E); PH_END(); } ++pc;
                if (PH_IN) { for (int rp = 0; rp <= PROBE_SPAT; ++rp) spatial_phase(act, vss + (size_t)j * MT, (const bf16*)(ws + WS_AWS) + (size_t)j * 16 * 128 * 128, a.in[10] + (size_t)j * D, a.in[12] + (size_t)j * 16 * 128, xn, M / 128, lds, gw, NGW, lane, wave); PH_END(); } ++pc;
            } else if (kind == 1) {
                if (PH_IN) { pg8::Gemm g{xn, (const bf16*)(ws + WS_BQKV), M, 6144, 2048}; pg8::StaticOrder S; S.init(M, 6144, 2048, G, bx);
                    pg8::EpiBf<2> E{act, 6144, qkss}; pg8::gemm_phase<pg8::EpiBf<2>, pg8::StaticOrder, true, true>(lds, g, S, E); PH_END(); } ++pc;
                if (PH_IN) { for (int rp = 0; rp <= PROBE_ATTN; ++rp) attn_phase(act, qkss, a.in[15], a.in[16], a.in[17], xn, lds, vcu, G, tid, lane, wave); PH_END(); } ++pc;
            } else {
                if (PH_IN) { pg8::Gemm g{xn, (const bf16*)(ws + WS_CWIN), M, 2048, 2048}; pg8::StaticOrder S; S.init(M, 2048, 2048, G, bx);
                    pg8::EpiBf<0> E{act, 2048, nullptr}; pg8::gemm_phase<pg8::EpiBf<0>, pg8::StaticOrder, true, true>(lds, g, S, E); PH_END(); } ++pc;
                if (PH_IN) { for (int rp = 0; rp <= PROBE_SCAN; ++rp) scan_phase(act, a.in[20], a.in[21], a.in[22], a.in[23], a.in[24], a.in[25], a.in[26], ybuf, lds, bx, G, wave, lane); PH_END(); } ++pc;
                if (PH_IN) { s5post_phase(act, ybuf, a.in[27], xn, M, gw, NGW, lane); PH_END(); } ++pc;
            }
            if (kind != 2) {
                if (PH_IN) { const bf16* wo = kind == 0 ? (const bf16*)(ws + WS_AWOUT) + (size_t)j * 2048 * 2048 : (const bf16*)(ws + WS_BWO);
                    pg8::Gemm g{xn, wo, M, 2048, 2048}; pg8::SplitOrder S; S.init(2048, 2048, G, bx, KSPLIT, M > ML);
                    pg8::EpiRes E{a.out, hc, a.out, hc, modl + 5 * D, slab, 1.0f}; pg8::gemm_phase<pg8::EpiRes, pg8::SplitOrder, true, true>(lds, g, S, E); PH_END(); } ++pc; pend = M > ML;
            } else {
                if (PH_IN) { pg8::Gemm g{xn, (const bf16*)(ws + WS_CGLU), M, 4096, 2048}; pg8::StaticOrder S; S.init(M, 4096, 2048, G, bx);
                    pg8::EpiGluRes E{a.out, hc, a.out, hc, modl + 5 * D}; pg8::gemm_phase<pg8::EpiGluRes, pg8::StaticOrder, true, true>(lds, g, S, E); PH_END(); } ++pc;
            }
        }
    }
#undef PH_IN
#undef PH_END
}

extern "C" void kernel_launch(void* const* d_in, const int* in_sizes, int n_in, void* d_out, int out_size, void* d_ws, size_t ws_size, hipStream_t stream) {
    static int grid = 0;
    if (grid == 0) {
        if (n_in != 29 || out_size != ML * D || ws_size < WS_END) { fprintf(stderr, "kernel_launch: unexpected shapes (n_in %d out %d ws %zu)\n", n_in, out_size, ws_size); grid = -1; return; }
        int dev = 0, cus = 0, per_cu = 0;
        if (hipGetDevice(&dev) != hipSuccess || hipDeviceGetAttribute(&cus, hipDeviceAttributeMultiprocessorCount, dev) != hipSuccess) { grid = -1; return; }
        if (hipFuncSetAttribute((const void*)fwd_kernel, hipFuncAttributeMaxDynamicSharedMemorySize, LDS_BYTES) != hipSuccess) { fprintf(stderr, "kernel_launch: hipFuncSetAttribute failed\n"); grid = -1; return; }
        if (hipOccupancyMaxActiveBlocksPerMultiprocessor(&per_cu, (const void*)fwd_kernel, NTHR, LDS_BYTES) != hipSuccess || per_cu < 1) fprintf(stderr, "kernel_launch: occupancy query says %d blocks per CU\n", per_cu);
        (void)hipGetLastError();
        grid = cus;
    }
    if (grid < 0) return;
    if (hipMemsetAsync(d_ws, 0, ZERO_BYTES, stream) != hipSuccess) { fprintf(stderr, "kernel_launch: memset failed\n"); return; }
    Args a{};
    for (int i = 0; i < 29; ++i) a.in[i] = (const float*)d_in[i];
    a.out = (float*)d_out; a.ws = (unsigned char*)d_ws; a.pad = 0;
#if MK_ONE_LAUNCH
    a.ph_lo = 0; a.ph_hi = NPHASES; a.li = 0;
    hipLaunchKernelGGL(fwd_kernel, dim3(grid), dim3(NTHR), LDS_BYTES, stream, a);
#else
    for (int k = 0; k < NPHASES; ++k) { a.ph_lo = k; a.ph_hi = k + 1; a.li = k;
        hipLaunchKernelGGL(fwd_kernel, dim3(grid), dim3(NTHR), LDS_BYTES, stream, a); }
#endif
    const hipError_t le = hipPeekAtLastError();
    if (le != hipSuccess) fprintf(stderr, "kernel_launch: launch failed: %s\n", hipGetErrorName(le));
}
```
